# Optimizing an MI355X kernel written in HIP

```python
import jax, jax.numpy as jnp
from jax import lax
import numpy as np

D_MODEL = 1024
BATCH = 32
SEQ = 2048
DEPTH = 1

MEM_LEN = 256
D_MIX = D_MODEL
SB_HEAD_DIM = 64
SB_WIDTH = D_MIX // 2
SB_HEADS = SB_WIDTH // SB_HEAD_DIM
POOL_WIDTH = D_MIX - SB_WIDTH
POOL_WINDOWS = (2, 4, 8, 16)
POOL_GROUPS = len(POOL_WINDOWS)
POOL_GROUP_DIM = POOL_WIDTH // POOL_GROUPS
IN_COLS = 3 * SB_WIDTH + POOL_WIDTH
Q_BLOCK = 128
MEM_HEADS = 4
MEM_HEAD_DIM = D_MODEL // MEM_HEADS
D_FF = 256 * ((8 * D_MODEL // 3 + 255) // 256)
FFN_RESIDUAL_WEIGHT = 0.5
EPS = 1e-6

kernel_name = "hybrid_stickbreaking_pool_macaron_layer"


def rmsnorm(x, g):
    xf = x.astype(jnp.float32)
    xf = xf * lax.rsqrt(jnp.mean(xf * xf, axis=-1, keepdims=True) + EPS)
    return xf.astype(x.dtype) * g


def swiglu(h, w_gate, w_up, w_down):
    return (jax.nn.silu(h @ w_gate) * (h @ w_up)) @ w_down


def stick_breaking_attention(q, k, v):
    S = q.shape[2]
    scale = q.shape[-1] ** -0.5
    outs = []
    for i in range(S // Q_BLOCK):
        q0 = i * Q_BLOCK
        kv_len = q0 + Q_BLOCK
        q_blk = q[:, :, q0:kv_len]
        k_pre = k[:, :, :kv_len]
        v_pre = v[:, :, :kv_len]
        z = jnp.einsum("bhqd,bhkd->bhqk", q_blk, k_pre).astype(jnp.float32) * scale
        q_pos = q0 + jnp.arange(Q_BLOCK)
        k_pos = jnp.arange(kv_len)
        strict = k_pos[None, :] < q_pos[:, None]
        log_rest = jnp.where(strict, jax.nn.log_sigmoid(-z), 0.0)
        suffix = lax.cumsum(log_rest, axis=3, reverse=True) - log_rest
        a = jnp.where(strict, jnp.exp(jax.nn.log_sigmoid(z) + suffix), 0.0)
        outs.append(jnp.einsum("bhqk,bhkd->bhqd", a.astype(v.dtype), v_pre))
    return jnp.concatenate(outs, axis=2)


def causal_multiscale_pool(u):
    B, S, _ = u.shape
    uf = u.astype(jnp.float32).reshape(B, S, POOL_GROUPS, POOL_GROUP_DIM)
    cs = jnp.concatenate([jnp.zeros_like(uf[:, :1]), jnp.cumsum(uf, axis=1)], axis=1)
    pos = jnp.arange(S)
    pooled = []
    for g, w in enumerate(POOL_WINDOWS):
        hi = cs[:, 1:, g]
        lo = cs[:, jnp.maximum(pos + 1 - w, 0), g]
        count = jnp.minimum(pos + 1, w).astype(jnp.float32)
        pooled.append((hi - lo) / count[None, :, None])
    pooled = jnp.stack(pooled, axis=2)
    return (pooled - uf).astype(u.dtype)


def memory_cross_attention(h, mem_n, w_q, w_kv, w_o):
    B, S, _ = h.shape
    M = mem_n.shape[1]
    q = (h @ w_q).reshape(B, S, MEM_HEADS, MEM_HEAD_DIM)
    kv = (mem_n @ w_kv).reshape(B, M, 2, MEM_HEADS, MEM_HEAD_DIM)
    k, v = kv[:, :, 0], kv[:, :, 1]
    s = jnp.einsum("bshd,bmhd->bhsm", q, k).astype(jnp.float32) * (MEM_HEAD_DIM ** -0.5)
    p = jax.nn.softmax(s, axis=-1).astype(v.dtype)
    o = jnp.einsum("bhsm,bmhd->bshd", p, v).reshape(B, S, D_MODEL)
    return o @ w_o


def parallel_head_group_mixer(h, w_in, w_pool, pool_scale, w_out):
    B, S, _ = h.shape
    proj = h @ w_in
    q, k, v, u = jnp.split(proj, [SB_WIDTH, 2 * SB_WIDTH, 3 * SB_WIDTH], axis=-1)
    to_heads = lambda t: t.reshape(B, S, SB_HEADS, SB_HEAD_DIM).transpose(0, 2, 1, 3)
    o_sb = stick_breaking_attention(to_heads(q), to_heads(k), to_heads(v))
    o_sb = o_sb.transpose(0, 2, 1, 3).reshape(B, S, SB_WIDTH)
    pooled = causal_multiscale_pool(u)
    o_pool = jnp.einsum("bsgc,gcd->bsgd", pooled, w_pool).reshape(B, S, POOL_WIDTH) * pool_scale
    return jnp.concatenate([o_sb, o_pool], axis=-1) @ w_out


def setup_inputs(seed: int = 0) -> dict:
    key = jax.random.key(seed)
    ks = jax.random.split(key, 24)

    def dense(k, shape, fan_in):
        return jax.random.normal(k, shape, jnp.float32) * fan_in ** -0.5

    def gain(k, shape):
        return 1.0 + 0.02 * jax.random.normal(k, shape, jnp.float32)

    L, D = DEPTH, D_MODEL
    return {
        "x": jax.random.normal(ks[0], (BATCH, SEQ, D), jnp.float32),
        "mem": jax.random.normal(ks[1], (BATCH, MEM_LEN, D), jnp.float32),
        "ffn1_norm": gain(ks[2], (L, D)),
        "ffn1_w_gate": dense(ks[3], (L, D, D_FF), D),
        "ffn1_w_up": dense(ks[4], (L, D, D_FF), D),
        "ffn1_w_down": dense(ks[5], (L, D_FF, D), D_FF),
        "mix_norm": gain(ks[6], (L, D)),
        "w_in": dense(ks[7], (L, D, IN_COLS), D),
        "w_pool": dense(ks[8], (L, POOL_GROUPS, POOL_GROUP_DIM, POOL_GROUP_DIM), POOL_GROUP_DIM),
        "pool_scale": gain(ks[9], (L, POOL_WIDTH)),
        "w_out": dense(ks[10], (L, D_MIX, D), D_MIX),
        "mem_q_norm": gain(ks[11], (L, D)),
        "mem_kv_norm": gain(ks[12], (L, D)),
        "mem_w_q": dense(ks[13], (L, D, D), D),
        "mem_w_kv": dense(ks[14], (L, D, 2 * D), D),
        "mem_w_o": dense(ks[15], (L, D, D), D),
        "ffn2_norm": gain(ks[16], (L, D)),
        "ffn2_w_gate": dense(ks[17], (L, D, D_FF), D),
        "ffn2_w_up": dense(ks[18], (L, D, D_FF), D),
        "ffn2_w_down": dense(ks[19], (L, D_FF, D), D_FF),
        "final_norm": gain(ks[20], (D,)),
    }


def reference(x, mem, ffn1_norm, ffn1_w_gate, ffn1_w_up, ffn1_w_down, mix_norm, w_in, w_pool,
              pool_scale, w_out, mem_q_norm, mem_kv_norm, mem_w_q, mem_w_kv, mem_w_o,
              ffn2_norm, ffn2_w_gate, ffn2_w_up, ffn2_w_down, final_norm):
    for l in range(DEPTH):
        x = x + FFN_RESIDUAL_WEIGHT * swiglu(rmsnorm(x, ffn1_norm[l]), ffn1_w_gate[l], ffn1_w_up[l], ffn1_w_down[l])
        x = x + parallel_head_group_mixer(rmsnorm(x, mix_norm[l]), w_in[l], w_pool[l], pool_scale[l], w_out[l])
        x = x + memory_cross_attention(rmsnorm(x, mem_q_norm[l]), rmsnorm(mem, mem_kv_norm[l]),
                                       mem_w_q[l], mem_w_kv[l], mem_w_o[l])
        x = x + FFN_RESIDUAL_WEIGHT * swiglu(rmsnorm(x, ffn2_norm[l]), ffn2_w_gate[l], ffn2_w_up[l], ffn2_w_down[l])
    return rmsnorm(x, final_norm)
```

```cpp
#include <hip/hip_runtime.h>
#include <hip/hip_cooperative_groups.h>
#include <cstdio>
#include <cstdint>
namespace cg = cooperative_groups;

#ifndef MK_LAUNCHES_PER_PHASE
#define MK_LAUNCHES_PER_PHASE 0
#endif

constexpr int BATCH = 32, SEQ = 2048, DM = 1024, T = BATCH * SEQ, DFF = 2816, MEM = 256, TM = BATCH * MEM;
constexpr int INC = 2048;
constexpr float LOG2E = 1.4426950408889634f;
constexpr float C2_SB = 0.125f * LOG2E;
constexpr float C2_MEM = 0.0625f * LOG2E;
constexpr float EPS = 1e-6f;

#define LAS __attribute__((address_space(3)))
typedef unsigned short bf16_t;
typedef short bf16x8 __attribute__((ext_vector_type(8)));
typedef short s16x4 __attribute__((ext_vector_type(4)));
typedef float f32x4 __attribute__((ext_vector_type(4)));
typedef float f32x16 __attribute__((ext_vector_type(16)));
typedef unsigned u32x4 __attribute__((ext_vector_type(4)));
typedef unsigned u32x2 __attribute__((ext_vector_type(2)));

__device__ __forceinline__ unsigned cvt_pk_bf16(float lo, float hi) { unsigned r; asm volatile("v_cvt_pk_bf16_f32 %0, %1, %2" : "=v"(r) : "v"(lo), "v"(hi)); return r; }
__device__ __forceinline__ float bf_lo(unsigned w) { return __uint_as_float(w << 16); }
__device__ __forceinline__ float bf_hi(unsigned w) { return __uint_as_float(w & 0xffff0000u); }
__device__ __forceinline__ float wave_sum(float v) {
#pragma unroll
    for (int o = 1; o < 64; o <<= 1) v += __shfl_xor(v, o);
    return v;
}
__device__ __forceinline__ float dot4(f32x4 v) { return (v[0] * v[0] + v[1] * v[1]) + (v[2] * v[2] + v[3] * v[3]); }
__device__ __forceinline__ float rstd4(f32x4 a) { return __builtin_amdgcn_rsqf(((a[0] + a[1]) + (a[2] + a[3])) * (1.f / DM) + EPS); }

namespace pg8 {
constexpr int BM = 256, BK = 64, HALF = 128, HTB = HALF * BK * 2, STAGE_BYTES = 8 * HTB, NXCD = 8, WGM = 8;
__host__ __device__ __forceinline__ int lds_byte(int r, int c) { const int st = (r >> 4) * 2 + (c >> 5), rr = r & 15, cc = c & 31, ob = rr * 64 + cc * 2; return st * 1024 + (ob ^ (((ob >> 9) & 1) << 5)); }
__host__ __device__ __forceinline__ void stage_rc(int b, int& R, int& C) { const int st = b / 1024, sb = b % 1024, swz = sb ^ (((sb >> 9) & 1) << 5); R = (st >> 1) * 16 + swz / 64; C = (st & 1) * 32 + (swz % 64) / 2; }
__host__ __device__ __forceinline__ int perm32(int rho) { const int n = rho >> 4, i = rho & 15; return 8 * (i >> 2) + 4 * n + (i & 3); }

struct Unit { int pm, pn; };
struct Gemm { const bf16_t* A; const bf16_t* Bt; int lda, ldb, K; long a_pm, a_pn, b_pn, b_pb; int pn_shift; long b_ph;
    __device__ __forceinline__ const char* abase(const Unit& u) const { return (const char*)A + (size_t)u.pm * a_pm + (size_t)(u.pn >> pn_shift) * a_pn; }
    __device__ __forceinline__ const char* bbase(const Unit& u) const { return (const char*)Bt + (size_t)(u.pn & ((1 << pn_shift) - 1)) * b_pn + (size_t)(u.pn >> pn_shift) * b_ph + (size_t)(u.pm >> 3) * b_pb; } };

struct StaticOrder {
    int nM, nN, nwg, G, c, rev;
    __device__ void init(int M, int N, int G_, int c_, int rev_ = 0) { nM = M / BM; nN = N / BM; nwg = nM * nN; G = G_; c = c_; rev = rev_; }
    __device__ bool next(int i, Unit& u) const {
        const long L = (long)i * G + c; if (L >= nwg) return false;
        int wgid = (int)L; { const int q = nwg / NXCD, r = nwg % NXCD, xcd = wgid % NXCD, off = wgid / NXCD; wgid = (xcd < r ? xcd * (q + 1) : r * (q + 1) + (xcd - r) * q) + off; }
        const int nig = WGM * nN, gid = wgid / nig, fm = gid * WGM, gsz = (nM - fm) < WGM ? (nM - fm) : WGM;
        u.pm = fm + ((wgid % nig) % gsz); u.pn = (wgid % nig) / gsz; if (rev) u.pm = nM - 1 - u.pm; return true;
    }
};

__device__ __forceinline__ void panel_rstd(const float* ssq, LAS unsigned char* scr, int pm, int wr, int fr, float (&rsv)[2][4]) {
    LAS float* rtab = (LAS float*)(scr + 4096); volatile LAS int* pf = (volatile LAS int*)(scr + 5120);
    if (*pf != pm) {
        asm volatile("s_waitcnt lgkmcnt(0)" ::: "memory"); __builtin_amdgcn_s_barrier(); asm volatile("" ::: "memory");
        const int t = threadIdx.x;
        if (t < BM) { rtab[t] = rstd4(*(const f32x4*)(ssq + (size_t)(pm * BM + t) * 4)); if (t == 0) *pf = pm; }
        asm volatile("s_waitcnt lgkmcnt(0)" ::: "memory"); __builtin_amdgcn_s_barrier(); asm volatile("" ::: "memory");
    }
#pragma unroll
    for (int ai = 0; ai < 2; ++ai)
#pragma unroll
        for (int m = 0; m < 4; ++m) rsv[ai][m] = rtab[ai * HALF + wr * 64 + m * 16 + fr];
}
typedef float f32x2 __attribute__((ext_vector_type(2)));
struct EpiSwiGLU {
    bf16_t* O; const float* ssq;
    __device__ __forceinline__ void operator()(const f32x4 (&acc)[2][2][4][2], const Unit& u, int wr, int wc, int fr, int fq, LAS unsigned char* scr) const {
        const int row0 = u.pm * BM + wr * 64 + fr, col0 = u.pn * HALF + wc * 32 + 8 * fq;
        float rsv[2][4]; panel_rstd(ssq, scr, u.pm, wr, fr, rsv);
#pragma unroll
        for (int ai = 0; ai < 2; ++ai)
#pragma unroll
            for (int m = 0; m < 4; ++m) {
                const int row = row0 + ai * HALF + m * 16; const float rs = rsv[ai][m], rs2 = rs * rs, ce = -rs * LOG2E; unsigned w[4];
#pragma unroll
                for (int n = 0; n < 2; ++n)
#pragma unroll
                    for (int j = 0; j < 4; j += 2) {
                        const f32x2 g = {acc[ai][0][m][n][j], acc[ai][0][m][n][j + 1]}, up = {acc[ai][1][m][n][j], acc[ai][1][m][n][j + 1]};
                        const f32x2 t = g * ce; f32x2 d; d.x = __builtin_amdgcn_exp2f(t.x); d.y = __builtin_amdgcn_exp2f(t.y); d = d + 1.0f;
                        f32x2 r; r.x = __builtin_amdgcn_rcpf(d.x); r.y = __builtin_amdgcn_rcpf(d.y);
                        const f32x2 o = (g * up) * (r * rs2); w[n * 2 + (j >> 1)] = cvt_pk_bf16(o.x, o.y); }
                *(u32x4*)(O + (size_t)row * DFF + col0) = (u32x4){w[0], w[1], w[2], w[3]}; }
    }
};
struct EpiResid {
    bf16_t* R; float* ssq; float alpha;
    __device__ __forceinline__ void operator()(const f32x4 (&acc)[2][2][4][2], const Unit& u, int wr, int wc, int fr, int fq, LAS unsigned char* scr) const {
        const int row0 = u.pm * BM + wr * 64 + fr, col0 = u.pn * BM + wc * 32 + 8 * fq;
        LAS float* tab = (LAS float*)scr;
        u32x4 bv[2][4][2];
#pragma unroll
        for (int ai = 0; ai < 2; ++ai)
#pragma unroll
            for (int m = 0; m < 4; ++m)
#pragma unroll
                for (int bj = 0; bj < 2; ++bj) bv[ai][m][bj] = *(const u32x4*)(R + (size_t)(row0 + ai * HALF + m * 16) * DM + col0 + bj * HALF);
#pragma unroll
        for (int ai = 0; ai < 2; ++ai)
#pragma unroll
            for (int m = 0; m < 4; ++m) {
                const int row = row0 + ai * HALF + m * 16; float s = 0.f;
#pragma unroll
                for (int bj = 0; bj < 2; ++bj) { const u32x4 b = bv[ai][m][bj];
                    const f32x4 b0 = {bf_lo(b.x), bf_hi(b.x), bf_lo(b.y), bf_hi(b.y)}, b1 = {bf_lo(b.z), bf_hi(b.z), bf_lo(b.w), bf_hi(b.w)};
                    const f32x4 v0 = b0 + acc[ai][bj][m][0] * alpha, v1 = b1 + acc[ai][bj][m][1] * alpha;
                    u32x4 w; w.x = cvt_pk_bf16(v0[0], v0[1]); w.y = cvt_pk_bf16(v0[2], v0[3]); w.z = cvt_pk_bf16(v1[0], v1[1]); w.w = cvt_pk_bf16(v1[2], v1[3]);
                    *(u32x4*)(R + (size_t)row * DM + col0 + bj * HALF) = w;
                    s += dot4(v0) + dot4(v1); }
                s += __shfl_xor(s, 16); s += __shfl_xor(s, 32); if (fq == 0) tab[(ai * HALF + wr * 64 + m * 16 + fr) * 4 + wc] = s;
            }
        asm volatile("s_waitcnt lgkmcnt(0)" ::: "memory"); __builtin_amdgcn_s_barrier(); asm volatile("" ::: "memory");
        const int t = threadIdx.x;
        if (t < BM) { const f32x4 v = *(const LAS f32x4*)(tab + t * 4); ssq[(size_t)(u.pm * BM + t) * 4 + u.pn] = (v[0] + v[1]) + (v[2] + v[3]); }
    }
};
struct EpiScale {
    bf16_t* O; int ldc; const float* ssq; long pm_stride, pn_stride; int pn_shift; long ph_stride;
    __device__ __forceinline__ void operator()(const f32x4 (&acc)[2][2][4][2], const Unit& u, int wr, int wc, int fr, int fq, LAS unsigned char* scr) const {
        const int lr0 = wr * 64 + fr, lc0 = wc * 32 + 8 * fq;
        bf16_t* Ot = O + (size_t)u.pm * pm_stride + (size_t)(u.pn & ((1 << pn_shift) - 1)) * pn_stride + (size_t)(u.pn >> pn_shift) * ph_stride;
        float rsv[2][4];
        if (ssq) panel_rstd(ssq, scr, u.pm, wr, fr, rsv);
        else {
#pragma unroll
            for (int ai = 0; ai < 2; ++ai)
#pragma unroll
                for (int m = 0; m < 4; ++m) rsv[ai][m] = 1.0f; }
#pragma unroll
        for (int ai = 0; ai < 2; ++ai)
#pragma unroll
            for (int m = 0; m < 4; ++m) {
                const int lr = lr0 + ai * HALF + m * 16; const float rs = rsv[ai][m];
#pragma unroll
                for (int bj = 0; bj < 2; ++bj) { const f32x4 v0 = acc[ai][bj][m][0] * rs, v1 = acc[ai][bj][m][1] * rs;
                    u32x4 w; w.x = cvt_pk_bf16(v0[0], v0[1]); w.y = cvt_pk_bf16(v0[2], v0[3]); w.z = cvt_pk_bf16(v1[0], v1[1]); w.w = cvt_pk_bf16(v1[2], v1[3]);
                    *(u32x4*)(Ot + (size_t)lr * ldc + lc0 + bj * HALF) = w; } }
    }
};
struct EpiSoftmax {
    bf16_t* P; const float* ssq;
    __device__ __forceinline__ void operator()(f32x4 (&acc)[2][2][4][2], const Unit& u, int wr, int wc, int fr, int fq, LAS unsigned char* scr) const {
        LAS float* tab = (LAS float*)scr;
        LAS float* tab2 = (LAS float*)(scr + 6144);
        float rsv[2][4]; panel_rstd(ssq, scr, u.pm, wr, fr, rsv);
#pragma unroll
        for (int ai = 0; ai < 2; ++ai)
#pragma unroll
            for (int m = 0; m < 4; ++m) {
                float mx = -3.0e38f; const float rs = rsv[ai][m];
#pragma unroll
                for (int bj = 0; bj < 2; ++bj)
#pragma unroll
                    for (int n = 0; n < 2; ++n) { acc[ai][bj][m][n] = acc[ai][bj][m][n] * rs; const f32x4 x = acc[ai][bj][m][n]; mx = fmaxf(mx, fmaxf(fmaxf(x[0], x[1]), fmaxf(x[2], x[3]))); }
                mx = fmaxf(mx, __shfl_xor(mx, 16)); mx = fmaxf(mx, __shfl_xor(mx, 32));
                if (fq == 0) tab[(ai * HALF + wr * 64 + m * 16 + fr) * 4 + wc] = mx;
            }
        asm volatile("s_waitcnt lgkmcnt(0)" ::: "memory"); __builtin_amdgcn_s_barrier(); asm volatile("" ::: "memory");
#pragma unroll
        for (int ai = 0; ai < 2; ++ai)
#pragma unroll
            for (int m = 0; m < 4; ++m) {
                const int lr = ai * HALF + wr * 64 + m * 16 + fr;
                const f32x4 t = *(const LAS f32x4*)(tab + lr * 4); const float mx = fmaxf(fmaxf(t[0], t[1]), fmaxf(t[2], t[3])); float sm = 0.f;
#pragma unroll
                for (int bj = 0; bj < 2; ++bj)
#pragma unroll
                    for (int n = 0; n < 2; ++n) { f32x4 v;
#pragma unroll
                        for (int j = 0; j < 4; ++j) v[j] = __builtin_amdgcn_exp2f(acc[ai][bj][m][n][j] - mx);
                        acc[ai][bj][m][n] = v; sm += (v[0] + v[1]) + (v[2] + v[3]); }
                sm += __shfl_xor(sm, 16); sm += __shfl_xor(sm, 32); if (fq == 0) tab2[lr * 4 + wc] = sm;
            }
        asm volatile("s_waitcnt lgkmcnt(0)" ::: "memory"); __builtin_amdgcn_s_barrier(); asm volatile("" ::: "memory");
        const int row0 = u.pm * BM + wr * 64 + fr, col0 = u.pn * BM + wc * 32 + 8 * fq;
#pragma unroll
        for (int ai = 0; ai < 2; ++ai)
#pragma unroll
            for (int m = 0; m < 4; ++m) {
                const int lr = ai * HALF + wr * 64 + m * 16 + fr, row = row0 + ai * HALF + m * 16;
                const f32x4 t = *(const LAS f32x4*)(tab2 + lr * 4); const float inv = 1.0f / ((t[0] + t[1]) + (t[2] + t[3]));
#pragma unroll
                for (int bj = 0; bj < 2; ++bj) { const f32x4 v0 = acc[ai][bj][m][0] * inv, v1 = acc[ai][bj][m][1] * inv;
                    u32x4 w; w.x = cvt_pk_bf16(v0[0], v0[1]); w.y = cvt_pk_bf16(v0[2], v0[3]); w.z = cvt_pk_bf16(v1[0], v1[1]); w.w = cvt_pk_bf16(v1[2], v1[3]);
                    *(u32x4*)(P + (size_t)row * DM + col0 + bj * HALF) = w; } }
    }
};

template <class Epi, int ESTORES = 0>
__device__ __forceinline__ void gemm_phase(LAS unsigned char* lds, LAS unsigned char* scr, const Gemm g, const StaticOrder& S, const Epi& E) {
    const int tid = threadIdx.x, wid = __builtin_amdgcn_readfirstlane(tid >> 6), lane = tid & 63, wr = wid >> 2, wc = wid & 3, fr = lane & 15, fq = lane >> 4;
    const int K = g.K, nt = K / BK;
    unsigned voffA[2], voffB[2];
#pragma unroll
    for (int i = 0; i < 2; ++i) { int R, C; stage_rc(tid * 16 + i * 8192, R, C); const int Rb = (R & ~31) + perm32(R & 31);
        voffA[i] = (unsigned)(R * g.lda + C) * 2u; voffB[i] = (unsigned)(Rb * g.ldb + C) * 2u; }
    const size_t kstep = (size_t)(BK * 2);
    const size_t hstepA = (size_t)HALF * g.lda * 2, hstepB = (size_t)HALF * g.ldb * 2;
    const unsigned ldsw = (unsigned)wid * 1024u; const unsigned ldsbase = (unsigned)(size_t)lds;
    const int aoff = lds_byte(wr * 64 + fr, fq * 8), boff = lds_byte(wc * 32 + fr, fq * 8);
#define PG8_SA(b, h) (((b) * 2 + (h)) * HTB)
#define PG8_SB(b, h) ((4 + (b) * 2 + (h)) * HTB)
#define PG8_STAGE(bufoff, gbase, voff) do { _Pragma("unroll") for (int _i = 0; _i < 2; ++_i) { unsigned _keep; \
        asm volatile("s_mov_b32 %0, m0\n\ts_mov_b32 m0, %3\n\ts_nop 0\n\tglobal_load_lds_dwordx4 %1, %2\n\ts_mov_b32 m0, %0" \
            : "=&s"(_keep) : "v"((voff)[_i]), "s"((const char*)(gbase)), "s"((unsigned)(ldsbase + (bufoff) + ldsw + _i * 8192)) : "memory"); } } while (0)
#define PG8_LDA(dst, b, h) do { _Pragma("unroll") for (int m = 0; m < 4; ++m) _Pragma("unroll") for (int k = 0; k < 2; ++k) dst[m][k] = *(const LAS bf16x8*)(lds + PG8_SA(b, h) + aoff + m * 2048 + k * 1024); } while (0)
#define PG8_LDB(dst, b, h) do { _Pragma("unroll") for (int n = 0; n < 2; ++n) _Pragma("unroll") for (int k = 0; k < 2; ++k) dst[n][k] = *(const LAS bf16x8*)(lds + PG8_SB(b, h) + boff + n * 2048 + k * 1024); } while (0)
#define PG8_MMA(ai, bj, At, Bt) do { __builtin_amdgcn_s_setprio(1); _Pragma("unroll") for (int m = 0; m < 4; ++m) _Pragma("unroll") for (int n = 0; n < 2; ++n) _Pragma("unroll") for (int k = 0; k < 2; ++k) \
        acc[ai][bj][m][n] = __builtin_amdgcn_mfma_f32_16x16x32_bf16(Bt[n][k], At[m][k], acc[ai][bj][m][n], 0, 0, 0); __builtin_amdgcn_s_setprio(0); } while (0)
#define PG8_WAIT_V(n) asm volatile("s_waitcnt vmcnt(" #n ")" ::: "memory")
#define PG8_WAIT_L(n) asm volatile("s_waitcnt lgkmcnt(" #n ")" ::: "memory")
#define PG8_BAR __builtin_amdgcn_s_barrier()
#define PG8_SCHED __builtin_amdgcn_sched_barrier(0)
    Unit cur, nxt; int ui = 0;
    if (!S.next(0, cur)) return;
    if (tid == 0) *(volatile LAS int*)(scr + 5120) = -1;
    f32x4 acc[2][2][4][2];
#pragma unroll
    for (int a = 0; a < 2; ++a)
#pragma unroll
        for (int b = 0; b < 2; ++b)
#pragma unroll
            for (int m = 0; m < 4; ++m)
#pragma unroll
                for (int n = 0; n < 2; ++n) acc[a][b][m][n] = (f32x4){0.f, 0.f, 0.f, 0.f};
    bf16x8 At[4][2], B0[2][2], B1[2][2];
    const char* cA = g.abase(cur);
    const char* cB = g.bbase(cur);
    PG8_STAGE(PG8_SB(0, 0), cB, voffB); PG8_STAGE(PG8_SB(0, 1), cB + hstepB, voffB); PG8_STAGE(PG8_SA(0, 0), cA, voffA); PG8_STAGE(PG8_SA(0, 1), cA + hstepA, voffA);
    if (wr == 1) PG8_BAR;
    PG8_WAIT_V(2); PG8_BAR;
    PG8_STAGE(PG8_SB(1, 0), cB + kstep, voffB); PG8_STAGE(PG8_SA(1, 0), cA + kstep, voffA); PG8_STAGE(PG8_SB(1, 1), cB + hstepB + kstep, voffB);
    PG8_WAIT_V(6); PG8_BAR;
    for (;;) {
        const bool has_next = S.next(ui + 1, nxt);
        const char* nA = has_next ? g.abase(nxt) : cA;
        const char* nB = has_next ? g.bbase(nxt) : cB;
#define PG8_TRIP(W) do { \
            const bool last = (t == nt - 2); \
            const char* a1 = cA + (size_t)(t + 1) * kstep; \
            const char* a2 = last ? nA : cA + (size_t)(t + 2) * kstep; const char* b2 = last ? nB : cB + (size_t)(t + 2) * kstep; \
            const char* a3 = a2 + kstep; const char* b3 = b2 + kstep; \
            PG8_LDB(B0, 0, 0); PG8_LDB(B1, 0, 1); PG8_SCHED; PG8_LDA(At, 0, 0); PG8_STAGE(PG8_SA(1, 1), a1 + hstepA, voffA); \
            PG8_WAIT_V(W); PG8_WAIT_L(0); PG8_BAR; PG8_MMA(0, 0, At, B0); PG8_MMA(0, 1, At, B1); PG8_BAR; PG8_SCHED; \
            PG8_LDA(At, 0, 1); PG8_STAGE(PG8_SB(0, 0), b2, voffB); PG8_STAGE(PG8_SB(0, 1), b2 + hstepB, voffB); PG8_STAGE(PG8_SA(0, 0), a2, voffA); \
            PG8_WAIT_V(W); PG8_WAIT_L(0); PG8_BAR; PG8_MMA(1, 0, At, B0); PG8_MMA(1, 1, At, B1); PG8_BAR; PG8_SCHED; \
            PG8_LDB(B0, 1, 0); PG8_LDB(B1, 1, 1); PG8_SCHED; PG8_LDA(At, 1, 0); PG8_STAGE(PG8_SA(0, 1), a2 + hstepA, voffA); \
            PG8_WAIT_V(8); PG8_WAIT_L(0); PG8_BAR; PG8_MMA(0, 0, At, B0); PG8_MMA(0, 1, At, B1); PG8_BAR; PG8_SCHED; \
            PG8_LDA(At, 1, 1); PG8_STAGE(PG8_SB(1, 0), b3, voffB); PG8_STAGE(PG8_SB(1, 1), b3 + hstepB, voffB); PG8_STAGE(PG8_SA(1, 0), a3, voffA); \
            PG8_WAIT_V(8); PG8_WAIT_L(0); PG8_BAR; PG8_MMA(1, 0, At, B0); PG8_MMA(1, 1, At, B1); PG8_BAR; PG8_SCHED; } while (0)
        int t = 0;
        if (ESTORES > 0 && ui > 0) { if constexpr (ESTORES == 8) PG8_TRIP(16); else if constexpr (ESTORES == 16) PG8_TRIP(24); else if constexpr (ESTORES == 32) PG8_TRIP(40); t = 2; }
        for (; t < nt; t += 2) PG8_TRIP(8);
#undef PG8_TRIP
        if (wr == 0) PG8_BAR;
        { int fr_o = fr, fq_o = fq; asm volatile("" : "+v"(fr_o), "+v"(fq_o));
          E(acc, cur, wr, wc, fr_o, fq_o, scr); }
        if (!has_next) break;
#pragma unroll
        for (int a = 0; a < 2; ++a)
#pragma unroll
            for (int b = 0; b < 2; ++b)
#pragma unroll
                for (int m = 0; m < 4; ++m)
#pragma unroll
                    for (int n = 0; n < 2; ++n) acc[a][b][m][n] = (f32x4){0.f, 0.f, 0.f, 0.f};
        cur = nxt; cA = nA; cB = nB; ++ui;
        if (wr == 1) PG8_BAR;
    }
    PG8_WAIT_V(0);
    PG8_BAR;
#undef PG8_SA
#undef PG8_SB
#undef PG8_STAGE
#undef PG8_LDA
#undef PG8_LDB
#undef PG8_MMA
#undef PG8_WAIT_V
#undef PG8_WAIT_L
#undef PG8_BAR
#undef PG8_SCHED
}
}

namespace sb {
constexpr int PITCH = INC;
constexpr int SLOTB = 8192, LDS_K = 0, LDS_V = 2 * SLOTB, LDS_FLAG = 4 * SLOTB, LDS_OST = LDS_FLAG + 256, LDS_BYTES = LDS_OST + 8 * 4096;
constexpr float DONE_THR = -150.0f;
typedef LAS const char* lds_cptr;
typedef short v4i16_t __attribute__((ext_vector_type(4)));
__device__ __forceinline__ int crow(int r, int hi) { return (r & 3) + 8 * (r >> 2) + 4 * hi; }
__device__ __forceinline__ void glds16(const void* gsrc, unsigned lds_dst) { unsigned keep;
    asm volatile("s_mov_b32 %0, m0\n\ts_mov_b32 m0, %2\n\ts_nop 0\n\tglobal_load_lds_dwordx4 %1, off\n\ts_mov_b32 m0, %0" : "=&s"(keep) : "v"(gsrc), "s"(lds_dst) : "memory"); }
__device__ __forceinline__ s16x4 vtr(lds_cptr p) { return __builtin_bit_cast(s16x4, __builtin_amdgcn_ds_read_tr16_b64_v4i16((LAS v4i16_t*)p)); }
__device__ __forceinline__ float xhalf(float v, int hi) {
    auto rr = __builtin_amdgcn_permlane32_swap(__float_as_uint(v), __float_as_uint(v), false, false);
    return __uint_as_float(hi ? rr[0] : rr[1]);
}
#define SB_WAIT_BAR(N) asm volatile("s_waitcnt vmcnt(" #N ") lgkmcnt(0)\n\ts_barrier" ::: "memory")

__device__ __forceinline__ void sb_tile(lds_cptr kp, lds_cptr vp, const bf16x8 (&qr)[4], f32x16 (&o)[2], float& carry, bool& wdone, bool diag, int kb, int tq, int hi, int ksw) {
    f32x16 p0 = f32x16{}, p1 = f32x16{};
#pragma unroll
    for (int d0 = 0; d0 < 4; ++d0) {
        const int ko = ((2 * d0 + hi) ^ ksw) * 16;
        const bf16x8 b0 = *(const LAS bf16x8*)(kp + ko), b1 = *(const LAS bf16x8*)(kp + ko + 4096);
        p0 = __builtin_amdgcn_mfma_f32_32x32x16_bf16(b0, qr[d0], p0, 0, 0, 0);
        p1 = __builtin_amdgcn_mfma_f32_32x32x16_bf16(b1, qr[d0], p1, 0, 0, 0); }
    f32x16 l0, l1;
#pragma unroll
    for (int r = 0; r < 16; ++r) {
        { const float z = fminf(p0[r], 126.f); const float L2 = __builtin_amdgcn_logf(1.0f + __builtin_amdgcn_exp2f(z)); l0[r] = -L2; p0[r] = z - L2; }
        { const float z = fminf(p1[r], 126.f); const float L2 = __builtin_amdgcn_logf(1.0f + __builtin_amdgcn_exp2f(z)); l1[r] = -L2; p1[r] = z - L2; }
    }
    if (diag) {
#pragma unroll
        for (int r = 0; r < 16; ++r) { const int kv = kb + (r & 3) + 8 * (r >> 2);
            if (kv >= tq) { l0[r] = 0.f; p0[r] = -1.0e30f; }
            if (kv + 32 >= tq) { l1[r] = 0.f; p1[r] = -1.0e30f; } }
    }
    float gs[8], ps[8];
#pragma unroll
    for (int g = 0; g < 4; ++g) { gs[g] = (l0[4 * g] + l0[4 * g + 1]) + (l0[4 * g + 2] + l0[4 * g + 3]); gs[4 + g] = (l1[4 * g] + l1[4 * g + 1]) + (l1[4 * g + 2] + l1[4 * g + 3]); }
#pragma unroll
    for (int g = 0; g < 8; ++g) ps[g] = xhalf(gs[g], hi);
    float run = carry;
#pragma unroll
    for (int g = 7; g >= 0; --g) {
        const float base = run + (hi ? 0.f : ps[g]);
        if (g >= 4) { const int q = 4 * (g - 4);
            const float e3 = base, e2 = e3 + l1[q + 3], e1 = e2 + l1[q + 2], e0 = e1 + l1[q + 1];
            p1[q + 3] = __builtin_amdgcn_exp2f(p1[q + 3] + e3); p1[q + 2] = __builtin_amdgcn_exp2f(p1[q + 2] + e2);
            p1[q + 1] = __builtin_amdgcn_exp2f(p1[q + 1] + e1); p1[q] = __builtin_amdgcn_exp2f(p1[q] + e0);
        } else { const int q = 4 * g;
            const float e3 = base, e2 = e3 + l0[q + 3], e1 = e2 + l0[q + 2], e0 = e1 + l0[q + 1];
            p0[q + 3] = __builtin_amdgcn_exp2f(p0[q + 3] + e3); p0[q + 2] = __builtin_amdgcn_exp2f(p0[q + 2] + e2);
            p0[q + 1] = __builtin_amdgcn_exp2f(p0[q + 1] + e1); p0[q] = __builtin_amdgcn_exp2f(p0[q] + e0);
        }
        run += gs[g] + ps[g];
    }
    carry = run;
    wdone = __all(carry < DONE_THR);
    u32x4 pw0, pw1, pw2, pw3;
    pw0 = (u32x4){cvt_pk_bf16(p0[0], p0[1]), cvt_pk_bf16(p0[2], p0[3]), cvt_pk_bf16(p0[4], p0[5]), cvt_pk_bf16(p0[6], p0[7])};
    pw1 = (u32x4){cvt_pk_bf16(p0[8], p0[9]), cvt_pk_bf16(p0[10], p0[11]), cvt_pk_bf16(p0[12], p0[13]), cvt_pk_bf16(p0[14], p0[15])};
    pw2 = (u32x4){cvt_pk_bf16(p1[0], p1[1]), cvt_pk_bf16(p1[2], p1[3]), cvt_pk_bf16(p1[4], p1[5]), cvt_pk_bf16(p1[6], p1[7])};
    pw3 = (u32x4){cvt_pk_bf16(p1[8], p1[9]), cvt_pk_bf16(p1[10], p1[11]), cvt_pk_bf16(p1[12], p1[13]), cvt_pk_bf16(p1[14], p1[15])};
#define SB_VFR(lo, hi_) (bf16x8){lo[0], lo[1], lo[2], lo[3], hi_[0], hi_[1], hi_[2], hi_[3]}
#pragma unroll
    for (int d0 = 0; d0 < 2; ++d0) {
        s16x4 vlo[4], vhi[4];
#pragma unroll
        for (int ks = 0; ks < 4; ++ks) { vlo[ks] = vtr(vp + d0 * 4096 + ks * 1024); vhi[ks] = vtr(vp + d0 * 4096 + ks * 1024 + 512); }
        o[d0] = __builtin_amdgcn_mfma_f32_32x32x16_bf16(__builtin_bit_cast(bf16x8, pw0), SB_VFR(vlo[0], vhi[0]), o[d0], 0, 0, 0);
        o[d0] = __builtin_amdgcn_mfma_f32_32x32x16_bf16(__builtin_bit_cast(bf16x8, pw1), SB_VFR(vlo[1], vhi[1]), o[d0], 0, 0, 0);
        o[d0] = __builtin_amdgcn_mfma_f32_32x32x16_bf16(__builtin_bit_cast(bf16x8, pw2), SB_VFR(vlo[2], vhi[2]), o[d0], 0, 0, 0);
        o[d0] = __builtin_amdgcn_mfma_f32_32x32x16_bf16(__builtin_bit_cast(bf16x8, pw3), SB_VFR(vlo[3], vhi[3]), o[d0], 0, 0, 0);
    }
#undef SB_VFR
}

constexpr int STG = 65536, V_OFF = 32768;
__device__ __forceinline__ void sb_unit8(int b, int hg, int qb2, const bf16_t* proj, bf16_t* mix, char* shm, volatile LAS unsigned* flag) {
    const int tid = threadIdx.x, lane = tid & 63, r32 = lane & 31, hi = lane >> 5; const int wid = __builtin_amdgcn_readfirstlane(tid >> 6);
    const int hh = wid >> 1, h = hg * 4 + hh, sub = wid & 1;
    const long rowbase = (long)b * SEQ; const int q0 = qb2 * 128;
    const unsigned lds0 = (unsigned)(uintptr_t)shm;
    const int krow = 8 * wid + (lane >> 3);
    const bf16_t* ksrc = proj + rowbase * PITCH + 512 + hg * 256 + (long)krow * PITCH + (((lane & 7) ^ ((krow >> 1) & 7)) * 8);
    const bf16_t* vsrc = proj + rowbase * PITCH + 1024 + hg * 256 + (long)(16 * (wid & 3) + (lane >> 2)) * PITCH + (wid >> 2) * 32 + (lane & 3) * 8;
    const unsigned kdst = lds0 + wid * 1024, vdst = lds0 + V_OFF + wid * 1024;
#define DMA_KV(t, stg) do { _Pragma("unroll") for (int x_ = 0; x_ < 4; ++x_) { \
        glds16(ksrc + x_ * 64 + (long)(t) * 64 * PITCH, (unsigned)__builtin_amdgcn_readfirstlane(kdst + (stg) + x_ * 8192)); \
        glds16(vsrc + x_ * 64 + (long)(t) * 64 * PITCH, (unsigned)__builtin_amdgcn_readfirstlane(vdst + (stg) + x_ * 8192)); } } while (0)
    const lds_cptr shm3 = (lds_cptr)shm;
    const lds_cptr kp0 = shm3 + hh * 8192 + r32 * 128; const int ksw = (r32 >> 1) & 7;
    const lds_cptr vp0 = shm3 + V_OFF + hh * 8192 + ((lane >> 4) & 1) * 32 + (lane & 3) * 8 + (4 * hi + ((lane & 15) >> 2)) * 64;
    const int jtop = 2 * qb2 + 1;
    DMA_KV(jtop, 0);
    bf16x8 qa[4], qb[4];
    {   const bf16_t* Qa = proj + (rowbase + q0 + 64 + sub * 32) * PITCH + h * 64; const bf16_t* Qb = proj + (rowbase + q0 + sub * 32) * PITCH + h * 64;
#pragma unroll
        for (int d0 = 0; d0 < 4; ++d0) { qa[d0] = *reinterpret_cast<const bf16x8*>(&Qa[(long)r32 * PITCH + d0 * 16 + hi * 8]); qb[d0] = *reinterpret_cast<const bf16x8*>(&Qb[(long)r32 * PITCH + d0 * 16 + hi * 8]); } }
    asm volatile("" : "+v"(qa[0]), "+v"(qa[1]), "+v"(qa[2]), "+v"(qa[3]), "+v"(qb[0]), "+v"(qb[1]), "+v"(qb[2]), "+v"(qb[3]));
    f32x16 oa[2], ob[2]; oa[0] = f32x16{}; oa[1] = f32x16{}; ob[0] = f32x16{}; ob[1] = f32x16{};
    float ca = 0.f, cb = 0.f; bool da = false, db = false;
    const int tqa = q0 + 64 + sub * 32 + r32, tqb = q0 + sub * 32 + r32;
    int stage = 0;
    for (int it = 0, j = jtop;; ++it, --j) {
        stage = (it & 1) * STG; const int nstage = STG - stage;
        if (j > 0) { DMA_KV(j - 1, nstage); SB_WAIT_BAR(8); } else { SB_WAIT_BAR(0); }
        const int kb = 64 * j + 4 * hi;
        if (!da) sb_tile(kp0 + stage, vp0 + stage, qa, oa, ca, da, j == jtop, kb, tqa, hi, ksw);
        if (!db && j < jtop) sb_tile(kp0 + stage, vp0 + stage, qb, ob, cb, db, j == jtop - 1, kb, tqb, hi, ksw);
        if (lane == 0) flag[wid] = (da && db) ? 1u : 0u;
        asm volatile("s_waitcnt lgkmcnt(0)\n\ts_barrier" ::: "memory");
        unsigned alld = 1u;
#pragma unroll
        for (int w = 0; w < 8; ++w) alld &= flag[w];
        if (alld || j == 0) break;
    }
    {   bf16_t* stg = (bf16_t*)(shm + stage) + wid * 4096;
#pragma unroll
        for (int r = 0; r < 16; ++r) { const int orow = crow(r, hi);
#pragma unroll
            for (int d0 = 0; d0 < 2; ++d0) { stg[orow * 64 + d0 * 32 + r32] = (bf16_t)(cvt_pk_bf16(oa[d0][r], 0.f) & 0xffffu); stg[2048 + orow * 64 + d0 * 32 + r32] = (bf16_t)(cvt_pk_bf16(ob[d0][r], 0.f) & 0xffffu); } }
        asm volatile("s_waitcnt lgkmcnt(0)" ::: "memory");
        bf16_t* Oa = mix + (rowbase + q0 + 64 + sub * 32) * DM + h * 64; bf16_t* Ob = mix + (rowbase + q0 + sub * 32) * DM + h * 64;
#pragma unroll
        for (int i = 0; i < 4; ++i) { const int row = i * 8 + (lane >> 3), ch = lane & 7;
            const u32x4 va = *(const u32x4*)(stg + row * 64 + ch * 8), vb = *(const u32x4*)(stg + 2048 + row * 64 + ch * 8);
            *(u32x4*)(Oa + (long)row * DM + ch * 8) = va; *(u32x4*)(Ob + (long)row * DM + ch * 8) = vb; } }
    asm volatile("s_waitcnt vmcnt(0) lgkmcnt(0)\n\ts_barrier" ::: "memory");
#undef DMA_KV
}
#undef SB_WAIT_BAR
}

#define XB_TMO      128
#define XB_XCNT(j)  (256  + 64 * (j))
#define XB_XSUB(j)  (1280 + 64 * (j))
#define XB_XGEN(j)  (2304 + 64 * (j))
#define XB_TOP      3328
#define XB_TOPGEN   3392
#define XCD_BAR_WORDS 3456
#define XB_SPIN_CAP (1u << 18)
__device__ __forceinline__ unsigned xb_ld(unsigned* p)              { return __hip_atomic_load(p, __ATOMIC_RELAXED, __HIP_MEMORY_SCOPE_AGENT); }
__device__ __forceinline__ unsigned xb_add(unsigned* p, unsigned v) { return __hip_atomic_fetch_add(p, v, __ATOMIC_RELAXED, __HIP_MEMORY_SCOPE_AGENT); }
__device__ __forceinline__ unsigned xb_xcc_id() { return (unsigned)__builtin_amdgcn_s_getreg((3 << 11) | 20) & 0xFu; }
#define XB_SPIN(cond, bar) do { unsigned _sp = 0; while (cond) { __builtin_amdgcn_s_sleep(1); \
    if ((++_sp & 255u) == 0u) { if (xb_ld(&(bar)[XB_TMO])) break; if (_sp > XB_SPIN_CAP) { atomicAdd(&(bar)[XB_TMO], 1u); break; } } } } while (0)
struct XcdBarrier { unsigned* bar; unsigned x; volatile LAS unsigned* st; };
__device__ __forceinline__ XcdBarrier xcd_barrier_post(unsigned* bar, volatile LAS unsigned* st) {
    XcdBarrier b; b.bar = bar; b.x = xb_xcc_id(); b.st = st;
    if (threadIdx.x == 0) (void)xb_add(&bar[XB_XCNT(b.x)], 1u);
    return b;
}
__device__ __forceinline__ void xcd_barrier_complete(unsigned* bar, unsigned x, unsigned& nloc, unsigned& nx) {
    const unsigned G = gridDim.x * gridDim.y * gridDim.z;
    unsigned sum, cnt, mine, sp = 0u;
    for (;;) {
        sum = 0u; cnt = 0u; mine = 0u;
#pragma unroll
        for (unsigned j = 0; j < 16; ++j) { const unsigned c = xb_ld(&bar[XB_XCNT(j)]); sum += c; cnt += (c > 0u) ? 1u : 0u; mine = (j == x) ? c : mine; }
        if (sum == G) break;
        __builtin_amdgcn_s_sleep(1);
        if ((++sp & 255u) == 0u) { if (xb_ld(&bar[XB_TMO])) break; if (sp > XB_SPIN_CAP) { atomicAdd(&bar[XB_TMO], 1u); break; } }
    }
    nloc = mine > 0u ? mine : 1u; nx = cnt > 0u ? cnt : 1u;
}
__device__ __forceinline__ void xcd_barrier(const XcdBarrier& b) {
    asm volatile("s_waitcnt vmcnt(0)" ::: "memory");
    __syncthreads();
    if (threadIdx.x == 0) {
        unsigned* bar = b.bar;
        __builtin_amdgcn_s_waitcnt(0);
        unsigned nloc = b.st[0], nx = b.st[1];
        if (nloc == 0u) { xcd_barrier_complete(bar, b.x, nloc, nx); b.st[0] = nloc; b.st[1] = nx; }
        const unsigned old = xb_add(&bar[XB_XSUB(b.x)], 1u);
        const unsigned gen = old / nloc;
        if (old + 1u == (gen + 1u) * nloc) {
            __builtin_amdgcn_fence(__ATOMIC_RELEASE, "agent");
            asm volatile("s_waitcnt vmcnt(0)" ::: "memory");
            const unsigned og = xb_add(&bar[XB_TOP], 1u);
            const unsigned tg = og / nx;
            if (og + 1u == (tg + 1u) * nx) xb_add(&bar[XB_TOPGEN], 1u);
            else XB_SPIN(xb_ld(&bar[XB_TOPGEN]) == tg, bar);
            __builtin_amdgcn_fence(__ATOMIC_ACQUIRE, "agent");
            xb_add(&bar[XB_XGEN(b.x)], 1u);
            asm volatile("s_waitcnt vmcnt(0)" ::: "memory");
        } else {
            XB_SPIN(xb_ld(&bar[XB_XGEN(b.x)]) == gen, bar);
            __builtin_amdgcn_fence(__ATOMIC_ACQUIRE, "agent");
            asm volatile("s_waitcnt vmcnt(0)" ::: "memory");
        }
    }
    __syncthreads();
}

constexpr size_t MiB = 1u << 20;
constexpr size_t WS_WGU1 = 1 * MiB, WS_WD1 = 12 * MiB, WS_WIN = 18 * MiB, WS_WOUT = 22 * MiB, WS_WQ = 24 * MiB, WS_WKV = 26 * MiB, WS_WO = 30 * MiB,
                 WS_WGU2 = 32 * MiB, WS_WD2 = 43 * MiB;
constexpr size_t WS_SSQ = 50 * MiB, WS_LSUM = 54 * MiB;
constexpr size_t WS_MEMN = 58 * MiB, WS_KM = 74 * MiB, WS_VT = 90 * MiB;
constexpr size_t WS_RB = 106 * MiB;
constexpr size_t WS_BIG = 234 * MiB;
constexpr size_t WS_PROJ = WS_BIG, WS_MIX = WS_BIG + 256 * MiB, WS_QM = WS_BIG, WS_PS = WS_BIG + 128 * MiB, WS_OM = WS_MIX;
constexpr size_t WS_KQT = WS_BIG + 384 * MiB, WS_VWOT = WS_KQT + 64 * MiB;
constexpr size_t WS_END = WS_VWOT + 64 * MiB;
static_assert(WS_WGU1 + (size_t)2 * DFF * DM * 2 <= WS_WD1 && WS_WD1 + (size_t)DM * DFF * 2 <= WS_WIN && WS_WGU2 + (size_t)2 * DFF * DM * 2 <= WS_WD2 && WS_WD2 + (size_t)DM * DFF * 2 <= WS_SSQ, "ws map");
static_assert((size_t)T * DFF * 2 <= 384 * MiB, "act fits");

constexpr int RING_BYTES = 131072, SCR_OFF = RING_BYTES, XBST_OFF = 143360, LDS_BYTES = 147456;
constexpr int NPHASE = 11;

struct Args { const float* in[21]; float* out; unsigned char* ws; int ph_lo, ph_hi; };

template <int W> __device__ __forceinline__ void pool_item(const bf16_t* __restrict__ y, bf16_t* __restrict__ o, int pos0) {
    u32x4 R[W - 1 + 16];
#pragma unroll
    for (int i = 0; i < W - 1; ++i) { const int d = W - 1 - i; R[i] = (pos0 - d >= 0) ? *(const u32x4*)(y - (ptrdiff_t)d * INC) : (u32x4){0u, 0u, 0u, 0u}; }
#pragma unroll
    for (int tt = 0; tt < 16; ++tt) R[W - 1 + tt] = *(const u32x4*)(y + (size_t)tt * INC);
    float sum[8];
#pragma unroll
    for (int e = 0; e < 8; ++e) sum[e] = 0.f;
#pragma unroll
    for (int i = 0; i < W - 1; ++i) { const u32x4 v = R[i];
        sum[0] += bf_lo(v.x); sum[1] += bf_hi(v.x); sum[2] += bf_lo(v.y); sum[3] += bf_hi(v.y); sum[4] += bf_lo(v.z); sum[5] += bf_hi(v.z); sum[6] += bf_lo(v.w); sum[7] += bf_hi(v.w); }
#pragma unroll
    for (int tt = 0; tt < 16; ++tt) { const u32x4 v = R[W - 1 + tt];
        const float cur[8] = {bf_lo(v.x), bf_hi(v.x), bf_lo(v.y), bf_hi(v.y), bf_lo(v.z), bf_hi(v.z), bf_lo(v.w), bf_hi(v.w)};
        const int pos = pos0 + tt; const float inv = 1.0f / (float)(pos + 1 < W ? pos + 1 : W); float r[8];
#pragma unroll
        for (int e = 0; e < 8; ++e) { sum[e] += cur[e]; r[e] = sum[e] * inv - cur[e]; }
        u32x4 wv; wv.x = cvt_pk_bf16(r[0], r[1]); wv.y = cvt_pk_bf16(r[2], r[3]); wv.z = cvt_pk_bf16(r[4], r[5]); wv.w = cvt_pk_bf16(r[6], r[7]);
        *(u32x4*)(o + (size_t)tt * DM) = wv;
        const u32x4 q = R[tt];
        sum[0] -= bf_lo(q.x); sum[1] -= bf_hi(q.x); sum[2] -= bf_lo(q.y); sum[3] -= bf_hi(q.y); sum[4] -= bf_lo(q.z); sum[5] -= bf_hi(q.z); sum[6] -= bf_lo(q.w); sum[7] -= bf_hi(q.w); }
}

__device__ __forceinline__ void p0_transpose_item(const float* W, int ldw, int colsrc, int K, const float* gain, float scale, bf16_t* WT, int drow0, int k0, LAS float* scr, int lane) {
    float wv[32];
#pragma unroll
    for (int i = 0; i < 32; ++i) { const int kk = 2 * i + (lane >> 5); wv[i] = __builtin_nontemporal_load(W + (size_t)(k0 + kk) * ldw + colsrc + (lane & 31)); }
#pragma unroll
    for (int i = 0; i < 32; ++i) { const int kk = 2 * i + (lane >> 5); const float gk = gain ? gain[k0 + kk] * scale : scale;
        scr[kk * 33 + (lane & 31)] = wv[i] * gk; }
    asm volatile("s_waitcnt lgkmcnt(0)" ::: "memory");
    const int c = lane & 7;
#pragma unroll
    for (int j = 0; j < 4; ++j) { const int n = (lane >> 3) + 8 * j; const LAS float* s = scr + (8 * c) * 33 + n;
        u32x4 o; o.x = cvt_pk_bf16(s[0 * 33], s[1 * 33]); o.y = cvt_pk_bf16(s[2 * 33], s[3 * 33]); o.z = cvt_pk_bf16(s[4 * 33], s[5 * 33]); o.w = cvt_pk_bf16(s[6 * 33], s[7 * 33]);
        *(u32x4*)(WT + (size_t)(drow0 + n) * K + k0 + 8 * c) = o; }
    asm volatile("s_waitcnt lgkmcnt(0)" ::: "memory");
}

__global__ void __launch_bounds__(512, 2) fwd_megakernel(Args args) {
    extern __shared__ __attribute__((aligned(16))) unsigned char lds[];
    LAS unsigned char* ldsl = (LAS unsigned char*)lds;
    const int tid = threadIdx.x, lane = tid & 63, wave = __builtin_amdgcn_readfirstlane(tid >> 6);
    const int G = gridDim.x, bx = blockIdx.x;
    const int gw = bx * 8 + wave, NGW = G * 8;
    unsigned char* ws = args.ws;
    const float* x = args.in[0]; const float* mem = args.in[1];
    float* out = args.out;
    bf16_t* Wgu1 = (bf16_t*)(ws + WS_WGU1); bf16_t* Wd1 = (bf16_t*)(ws + WS_WD1); bf16_t* Win = (bf16_t*)(ws + WS_WIN); bf16_t* Wout = (bf16_t*)(ws + WS_WOUT);
    bf16_t* Wq = (bf16_t*)(ws + WS_WQ); bf16_t* Wkv = (bf16_t*)(ws + WS_WKV); bf16_t* Wo = (bf16_t*)(ws + WS_WO); bf16_t* Wgu2 = (bf16_t*)(ws + WS_WGU2); bf16_t* Wd2 = (bf16_t*)(ws + WS_WD2);
    float* ssq = (float*)(ws + WS_SSQ);
    bf16_t* memn = (bf16_t*)(ws + WS_MEMN); bf16_t* KV = (bf16_t*)(ws + WS_KM);
    bf16_t* KqT = (bf16_t*)(ws + WS_KQT); bf16_t* VWoT = (bf16_t*)(ws + WS_VWOT);
    bf16_t* Rb = (bf16_t*)(ws + WS_RB); bf16_t* act = (bf16_t*)(ws + WS_BIG); bf16_t* proj = (bf16_t*)(ws + WS_PROJ); bf16_t* mix = (bf16_t*)(ws + WS_MIX);
    bf16_t* Ps = (bf16_t*)(ws + WS_PS);
    const int lo = args.ph_lo, hi = args.ph_hi;
    cg::grid_group grid = cg::this_grid();
#define IN(k) (lo <= (k) && (k) < hi)
    unsigned* barw = (unsigned*)ws;
    unsigned* readyw = barw + 4096;
    constexpr unsigned READY_MAGIC = 0x600DF00Du;
    volatile LAS unsigned* xbst = (volatile LAS unsigned*)(ldsl + XBST_OFF);
    if (tid < 4) xbst[tid] = 0u;
    __syncthreads();
    if (lo < 0) grid.sync();
    if (bx == 0) {
        for (int i = tid; i < XCD_BAR_WORDS; i += 512) barw[i] = 0u;
        __threadfence(); __syncthreads();
        if (tid == 0) { __builtin_amdgcn_fence(__ATOMIC_RELEASE, "agent"); asm volatile("s_waitcnt vmcnt(0)" ::: "memory"); __hip_atomic_store(readyw, READY_MAGIC, __ATOMIC_RELAXED, __HIP_MEMORY_SCOPE_AGENT); }
    }
    XcdBarrier xbar; xbar.bar = barw; xbar.x = 0; xbar.st = xbst;
#define SEAM(k) do { if (IN(k) && IN((k) + 1)) { if ((k) == 0) { \
        if (tid == 0) { unsigned sp_ = 0; while (__hip_atomic_load(readyw, __ATOMIC_RELAXED, __HIP_MEMORY_SCOPE_AGENT) != READY_MAGIC) { __builtin_amdgcn_s_sleep(1); if (++sp_ > (1u << 22)) break; } \
            __builtin_amdgcn_fence(__ATOMIC_ACQUIRE, "agent"); asm volatile("s_waitcnt vmcnt(0)" ::: "memory"); } \
        __syncthreads(); xbar = xcd_barrier_post(barw, xbst); } \
        xcd_barrier(xbar); } } while (0)
#ifndef PROBE_DUP
#define PROBE_DUP 0
#endif
#define REP(k) for (int rep_ = 0; rep_ < 1 + ((PROBE_DUP >> (k)) & 1); ++rep_)

    if (IN(0)) REP(0) {
        LAS float* scr = (LAS float*)(ldsl + wave * 16384);
        constexpr int I_G = (DM / 64) * (DFF / 32), I_D = (DFF / 64) * (DM / 32), I_INQ = 16 * 16, I_INKV = 16 * 32, I_SQ = 16 * 32, I_KV = 16 * 64;
        constexpr int NITEMS = 4 * I_G + 2 * I_D + I_INQ + I_INKV + 2 * I_SQ + I_KV;
        for (int it = gw; it < NITEMS; it += NGW) {
            int r = it; const float* W; int ldw, col0 = 0, K = DM, N; const float* gain = nullptr; float scale = 1.f; bf16_t* WT; int rmode = 0, roff = 0;
            if (r < I_G) { W = args.in[3]; ldw = DFF; N = DFF; gain = args.in[2]; WT = Wgu1; rmode = 1; }
            else if ((r -= I_G) < I_G) { W = args.in[4]; ldw = DFF; N = DFF; gain = args.in[2]; WT = Wgu1; rmode = 2; }
            else if ((r -= I_G) < I_D) { W = args.in[5]; ldw = DM; N = DM; K = DFF; WT = Wd1; }
            else if ((r -= I_D) < I_INQ) { W = args.in[7]; ldw = INC; N = 512; gain = args.in[6]; scale = C2_SB; WT = Win; }
            else if ((r -= I_INQ) < I_INKV) { W = args.in[7]; ldw = INC; col0 = 512; N = 1024; gain = args.in[6]; WT = Win; roff = 512; }
            else if ((r -= I_INKV) < I_SQ) { W = args.in[10]; ldw = DM; N = DM; WT = Wout; }
            else if ((r -= I_SQ) < I_KV) { W = args.in[14]; ldw = 2 * DM; N = 2 * DM; WT = Wkv; }
            else if ((r -= I_KV) < I_SQ) { W = args.in[15]; ldw = DM; N = DM; WT = Wo; }
            else if ((r -= I_SQ) < I_G) { W = args.in[17]; ldw = DFF; N = DFF; gain = args.in[16]; WT = Wgu2; rmode = 1; }
            else if ((r -= I_G) < I_G) { W = args.in[18]; ldw = DFF; N = DFF; gain = args.in[16]; WT = Wgu2; rmode = 2; }
            else { r -= I_G; W = args.in[19]; ldw = DM; N = DM; K = DFF; WT = Wd2; }
            const int nblk = N / 32, kb = r / nblk, nb = r % nblk, k0 = 64 * kb, n0 = 32 * nb;
            const int drow0 = rmode == 0 ? roff + n0 : (n0 >> 7) * 256 + (rmode == 2 ? 128 : 0) + (n0 & 127);
            p0_transpose_item(W, ldw, col0 + n0, K, gain, scale, WT, drow0, k0, scr, lane);
        }
        if ((wave & 3) == 0) {
            const float* w_in = args.in[7]; const float* w_pool = args.in[8]; const float* pscale = args.in[9]; const float* gmix = args.in[6];
            for (int item = bx * 2 + (wave >> 2); item < 16 * 32; item += G * 2) {
                const int k = (item & 15) * 64 + lane, gd0 = item >> 4, g = gd0 >> 3, d0 = (gd0 & 7) * 16;
                const float* wr = w_in + (size_t)k * INC + 1536 + g * 128; const float* wp = w_pool + (size_t)g * 128 * 128 + d0;
                f32x4 a0 = {0.f, 0.f, 0.f, 0.f}, a1 = a0, a2 = a0, a3 = a0;
#pragma unroll 2
                for (int c = 0; c < 128; c += 4) { const f32x4 av = *(const f32x4*)(wr + c);
#pragma unroll
                    for (int e = 0; e < 4; ++e) { const f32x4* w4 = (const f32x4*)(wp + (size_t)(c + e) * 128); const float ae = av[e];
                        a0 += w4[0] * ae; a1 += w4[1] * ae; a2 += w4[2] * ae; a3 += w4[3] * ae; } }
                const float gk = gmix[k]; const f32x4* ps4 = (const f32x4*)(pscale + g * 128 + d0);
                a0 = a0 * ps4[0] * gk; a1 = a1 * ps4[1] * gk; a2 = a2 * ps4[2] * gk; a3 = a3 * ps4[3] * gk;
                bf16_t* o = Win + (size_t)(1536 + g * 128 + d0) * DM + k;
#pragma unroll
                for (int e = 0; e < 4; ++e) { o[(size_t)(e) * DM] = (bf16_t)(cvt_pk_bf16(a0[e], 0.f) & 0xffffu); o[(size_t)(4 + e) * DM] = (bf16_t)(cvt_pk_bf16(a1[e], 0.f) & 0xffffu);
                    o[(size_t)(8 + e) * DM] = (bf16_t)(cvt_pk_bf16(a2[e], 0.f) & 0xffffu); o[(size_t)(12 + e) * DM] = (bf16_t)(cvt_pk_bf16(a3[e], 0.f) & 0xffffu); }
            }
        }
        for (int m = gw; m < DM; m += NGW) {
            const f32x4* wr4 = (const f32x4*)(args.in[13] + (size_t)m * DM) + lane; const float gk = args.in[11][m] * C2_MEM; u32x2* o8 = (u32x2*)(Wq + (size_t)m * DM) + lane;
#pragma unroll
            for (int j = 0; j < 4; ++j) { const f32x4 v = wr4[64 * j] * gk; o8[64 * j] = (u32x2){cvt_pk_bf16(v[0], v[1]), cvt_pk_bf16(v[2], v[3])}; }
        }
        for (int m0 = gw * 4; m0 < T; m0 += NGW * 4) {
            f32x4 v[4][4]; float s[4];
#pragma unroll
            for (int r = 0; r < 4; ++r) { const f32x4* xr = (const f32x4*)(x + (size_t)(m0 + r) * DM) + lane;
#pragma unroll
                for (int j = 0; j < 4; ++j) v[r][j] = __builtin_nontemporal_load(xr + 64 * j); }
#pragma unroll
            for (int r = 0; r < 4; ++r) { s[r] = 0.f;
#pragma unroll
                for (int j = 0; j < 4; ++j) s[r] += dot4(v[r][j]);
                s[r] = wave_sum(s[r]);
                u32x2* o8 = (u32x2*)(Rb + (size_t)(m0 + r) * DM) + lane;
#pragma unroll
                for (int j = 0; j < 4; ++j) o8[64 * j] = (u32x2){cvt_pk_bf16(v[r][j][0], v[r][j][1]), cvt_pk_bf16(v[r][j][2], v[r][j][3])};
                if (lane < 4) ssq[(size_t)(m0 + r) * 4 + lane] = lane == 0 ? s[r] : 0.f; }
        }
        for (int m = gw; m < TM; m += NGW) {
            const f32x4* xr = (const f32x4*)(mem + (size_t)m * DM) + lane; const f32x4* gr = (const f32x4*)args.in[12] + lane; f32x4 v[4]; float s = 0.f;
#pragma unroll
            for (int j = 0; j < 4; ++j) { v[j] = xr[64 * j]; s += dot4(v[j]); }
            const float rs = __builtin_amdgcn_rsqf(wave_sum(s) * (1.f / DM) + EPS);
            u32x2* o8 = (u32x2*)(memn + (size_t)m * DM) + lane;
#pragma unroll
            for (int j = 0; j < 4; ++j) { const f32x4 gg = gr[64 * j]; const f32x4 y = v[j] * rs * gg; o8[64 * j] = (u32x2){cvt_pk_bf16(y[0], y[1]), cvt_pk_bf16(y[2], y[3])}; }
        }
        __syncthreads();
    }
    SEAM(0);
    if (IN(1)) REP(1) {
        pg8::Gemm g{Rb, Wgu1, DM, DM, DM, (long)256 * DM * 2, 0, (long)256 * DM * 2, 0, 30, 0}; pg8::StaticOrder S; S.init(T, 2 * DFF, G, bx, 1);
        pg8::EpiSwiGLU E{act, ssq};
        pg8::gemm_phase<pg8::EpiSwiGLU, 8>(ldsl, ldsl + SCR_OFF, g, S, E);
    }
    SEAM(1);
    if (IN(2)) REP(2) {
        pg8::Gemm g{act, Wd1, DFF, DFF, DFF, (long)256 * DFF * 2, 0, (long)256 * DFF * 2, 0, 30, 0}; pg8::StaticOrder S; S.init(T, DM, G, bx);
        pg8::EpiResid E{Rb, ssq, 0.5f};
        pg8::gemm_phase<pg8::EpiResid, 32>(ldsl, ldsl + SCR_OFF, g, S, E);
    }
    SEAM(2);
    if (IN(3)) REP(3) {
        {   pg8::Gemm g{Rb, Win, DM, DM, DM, (long)256 * DM * 2, 0, (long)256 * DM * 2, 0, 30, 0}; pg8::StaticOrder S; S.init(T, INC, G, bx, 1);
            pg8::EpiScale E{proj, INC, ssq, (long)256 * INC, 256, 30, 0};
            pg8::gemm_phase<pg8::EpiScale, 16>(ldsl, ldsl + SCR_OFF, g, S, E); }
        {
            pg8::Gemm g{memn, Wkv, DM, DM, DM, (long)256 * DM * 2, 0, (long)256 * DM * 2, 0, 30, 0}; pg8::StaticOrder S; S.init(TM, 2 * DM, G, bx);
            pg8::EpiScale E{KV, 2 * DM, nullptr, (long)256 * 2 * DM, 256, 30, 0};
            pg8::gemm_phase<pg8::EpiScale, 16>(ldsl, ldsl + SCR_OFF, g, S, E); }
    }
    SEAM(3);
    if (IN(4)) REP(4) {
        for (int u = bx; u < BATCH * 2 * 16; u += G) {
            const int i = u >> 8, xcd = u & 7, l = (u >> 3) & 31, qb2 = ((l & 15) + 5 * i) & 15, bh2 = (xcd + 8 * i) * 2 + (l >> 4);
            sb::sb_unit8(bh2 >> 1, bh2 & 1, qb2, proj, mix, (char*)lds, (volatile LAS unsigned*)(ldsl + SCR_OFF)); }
        for (int item = gw; item < (T / 64) * 4; item += NGW) {
            const int g = item & 3, t0 = (item >> 2) * 64 + (lane >> 4) * 16, c0 = g * 128 + (lane & 15) * 8;
            const bf16_t* y = proj + (size_t)t0 * INC + 1536 + c0; bf16_t* o = mix + (size_t)t0 * DM + 512 + c0; const int pos0 = t0 & (SEQ - 1);
            if (g == 0) pool_item<2>(y, o, pos0); else if (g == 1) pool_item<4>(y, o, pos0); else if (g == 2) pool_item<8>(y, o, pos0); else pool_item<16>(y, o, pos0);
        }
        __syncthreads();
        {
            pg8::Gemm g{KV, Wq, 2 * DM, DM, 256, (long)256 * 2 * DM * 2, 256 * 2, (long)256 * DM * 2, 0, 2, 256 * 2}; pg8::StaticOrder S; S.init(TM, 4 * DM, G, bx);
            pg8::EpiScale E{KqT, DM, nullptr, (long)DM * DM, 256, 2, (long)256 * DM};
            pg8::gemm_phase<pg8::EpiScale, 16>(ldsl, ldsl + SCR_OFF, g, S, E); }
        {
            pg8::Gemm g{Wo, KV + DM, DM, 2 * DM, 256, (long)256 * DM * 2, 256 * 2, (long)256 * 2 * DM * 2, 0, 5, 256 * 2}; pg8::StaticOrder S; S.init(DM, 4 * TM, G, bx);
            pg8::EpiScale E{VWoT, DM, nullptr, (long)256 * DM, (long)DM * DM, 5, 256};
            pg8::gemm_phase<pg8::EpiScale, 16>(ldsl, ldsl + SCR_OFF, g, S, E); }
    }
    SEAM(4);
    if (IN(5)) {
        pg8::Gemm g{mix, Wout, DM, DM, DM, (long)256 * DM * 2, 0, (long)256 * DM * 2, 0, 30, 0}; pg8::StaticOrder S; S.init(T, DM, G, bx, 1);
        pg8::EpiResid E{Rb, ssq, 1.0f};
        pg8::gemm_phase<pg8::EpiResid, 32>(ldsl, ldsl + SCR_OFF, g, S, E);
    }
    SEAM(5);
    if (IN(6)) REP(6) {
        pg8::Gemm g{Rb, KqT, DM, DM, DM, (long)256 * DM * 2, 0, 0, (long)DM * DM * 2, 0, (long)256 * DM * 2}; pg8::StaticOrder S; S.init(T, DM, G, bx);
        pg8::EpiSoftmax E{Ps, ssq};
        pg8::gemm_phase<pg8::EpiSoftmax, 16>(ldsl, ldsl + SCR_OFF, g, S, E);
    }
    SEAM(6);
    if (IN(7)) {
        pg8::Gemm g{Ps, VWoT, DM, DM, DM, (long)256 * DM * 2, 0, (long)256 * DM * 2, (long)DM * DM * 2, 30, 0}; pg8::StaticOrder S; S.init(T, DM, G, bx, 1);
        pg8::EpiResid E{Rb, ssq, 1.0f};
        pg8::gemm_phase<pg8::EpiResid, 32>(ldsl, ldsl + SCR_OFF, g, S, E);
    }
    SEAM(7);
    if (IN(8)) REP(8) {
        pg8::Gemm g{Rb, Wgu2, DM, DM, DM, (long)256 * DM * 2, 0, (long)256 * DM * 2, 0, 30, 0}; pg8::StaticOrder S; S.init(T, 2 * DFF, G, bx);
        pg8::EpiSwiGLU E{act, ssq};
        pg8::gemm_phase<pg8::EpiSwiGLU, 8>(ldsl, ldsl + SCR_OFF, g, S, E);
    }
    SEAM(8);
    if (IN(9)) {
        pg8::Gemm g{act, Wd2, DFF, DFF, DFF, (long)256 * DFF * 2, 0, (long)256 * DFF * 2, 0, 30, 0}; pg8::StaticOrder S; S.init(T, DM, G, bx, 1);
        pg8::EpiResid E{Rb, ssq, 0.5f};
        pg8::gemm_phase<pg8::EpiResid, 32>(ldsl, ldsl + SCR_OFF, g, S, E);
    }
    SEAM(9);
    if (IN(10)) {
        const f32x4* gr = (const f32x4*)args.in[20]; f32x4 g0[2], g1[2];
#pragma unroll
        for (int j = 0; j < 2; ++j) { g0[j] = gr[(lane + 64 * j) * 2]; g1[j] = gr[(lane + 64 * j) * 2 + 1]; }
        for (int m0 = gw * 8; m0 < T; m0 += NGW * 8) {
            u32x4 v[8][2]; f32x4 sq[8];
#pragma unroll
            for (int r = 0; r < 8; ++r) { const u32x4* xr = (const u32x4*)(Rb + (size_t)(m0 + r) * DM) + lane; v[r][0] = xr[0]; v[r][1] = xr[64]; sq[r] = *(const f32x4*)(ssq + (size_t)(m0 + r) * 4); }
#pragma unroll
            for (int r = 0; r < 8; ++r) { const float rs = rstd4(sq[r]); f32x4* xw = (f32x4*)(out + (size_t)(m0 + r) * DM);
#pragma unroll
                for (int j = 0; j < 2; ++j) { const u32x4 b = v[r][j];
                    const f32x4 b0 = {bf_lo(b.x), bf_hi(b.x), bf_lo(b.y), bf_hi(b.y)}, b1 = {bf_lo(b.z), bf_hi(b.z), bf_lo(b.w), bf_hi(b.w)};
                    __builtin_nontemporal_store(b0 * rs * g0[j], xw + (lane + 64 * j) * 2); __builtin_nontemporal_store(b1 * rs * g1[j], xw + (lane + 64 * j) * 2 + 1); } }
        }
    }
    if (bx == 0 && tid == 0) __hip_atomic_store(readyw, 0u, __ATOMIC_RELAXED, __HIP_MEMORY_SCOPE_AGENT);
#undef IN
#undef SEAM
}

extern "C" void kernel_launch(void* const* d_in, const int* in_sizes, int n_in, void* d_out, int out_size, void* d_ws, size_t ws_size, hipStream_t stream) {
    static int grid = 0;
    if (grid == 0) {
        if (n_in != 21 || out_size != T * DM || ws_size < WS_END) { fprintf(stderr, "kernel_launch: unexpected problem (n_in %d out %d ws %zu)\n", n_in, out_size, ws_size); grid = -1; return; }
        int dev = 0, cus = 0, per_cu = 0;
        hipGetDevice(&dev); hipDeviceGetAttribute(&cus, hipDeviceAttributeMultiprocessorCount, dev);
        if (hipFuncSetAttribute((const void*)fwd_megakernel, hipFuncAttributeMaxDynamicSharedMemorySize, LDS_BYTES) != hipSuccess) { fprintf(stderr, "kernel_launch: hipFuncSetAttribute failed\n"); grid = -1; return; }
        if (hipOccupancyMaxActiveBlocksPerMultiprocessor(&per_cu, (const void*)fwd_megakernel, 512, LDS_BYTES) != hipSuccess || per_cu < 1) { fprintf(stderr, "kernel_launch: occupancy query says %d\n", per_cu); per_cu = 1; }
        (void)hipGetLastError();
        grid = cus * 1;
        (void)per_cu;
    }
    if (grid < 0) return;
    Args a{};
    for (int i = 0; i < 21; ++i) a.in[i] = (const float*)d_in[i];
    a.out = (float*)d_out; a.ws = (unsigned char*)d_ws;
#if MK_LAUNCHES_PER_PHASE
    for (int p = 0; p < NPHASE; ++p) { a.ph_lo = p; a.ph_hi = p + 1; hipLaunchKernelGGL(fwd_megakernel, dim3(grid), dim3(512), LDS_BYTES, stream, a); }
#else
    a.ph_lo = 0; a.ph_hi = NPHASE;
    void* kargs[] = {&a};
    hipError_t e = hipLaunchCooperativeKernel((const void*)fwd_megakernel, dim3(grid), dim3(512), kargs, LDS_BYTES, stream);
    if (e != hipSuccess) fprintf(stderr, "cooperative launch failed: %s (grid %d)\n", hipGetErrorString(e), grid);
#endif
}
```

```cpp
#include <hip/hip_runtime.h>
#include <hip/hip_cooperative_groups.h>
#include <cstdio>
#include <cstdint>
namespace cg = cooperative_groups;

#ifndef MK_LAUNCHES_PER_PHASE
#define MK_LAUNCHES_PER_PHASE 0
#endif

constexpr int BATCH = 32, SEQ = 2048, DM = 1024, T = BATCH * SEQ, DFF = 2816, MEM = 256, TM = BATCH * MEM;
constexpr int INC = 2048;
constexpr float LOG2E = 1.4426950408889634f;
constexpr float C2_SB = 0.125f * LOG2E;
constexpr float C2_MEM = 0.0625f * LOG2E;
constexpr float EPS = 1e-6f;
constexpr long X8_FROM_RB = (long)(234 + 128 + 64 - 106) * 1048576;

#define LAS __attribute__((address_space(3)))
typedef unsigned short bf16_t;
typedef short bf16x8 __attribute__((ext_vector_type(8)));
typedef short s16x4 __attribute__((ext_vector_type(4)));
typedef float f32x4 __attribute__((ext_vector_type(4)));
typedef float f32x16 __attribute__((ext_vector_type(16)));
typedef unsigned u32x4 __attribute__((ext_vector_type(4)));
typedef unsigned u32x2 __attribute__((ext_vector_type(2)));
typedef int v8i32 __attribute__((ext_vector_type(8)));

__device__ __forceinline__ unsigned cvt_pk_bf16(float lo, float hi) { unsigned r; asm volatile("v_cvt_pk_bf16_f32 %0, %1, %2" : "=v"(r) : "v"(lo), "v"(hi)); return r; }
__device__ __forceinline__ unsigned pk4_fp8(float a, float b, float c, float d) { int w = 0; w = __builtin_amdgcn_cvt_pk_fp8_f32(a, b, w, false); w = __builtin_amdgcn_cvt_pk_fp8_f32(c, d, w, true); return (unsigned)w; }
__device__ __forceinline__ float bf_lo(unsigned w) { return __uint_as_float(w << 16); }
__device__ __forceinline__ float bf_hi(unsigned w) { return __uint_as_float(w & 0xffff0000u); }
__device__ __forceinline__ float wave_sum(float v) {
#pragma unroll
    for (int o = 1; o < 64; o <<= 1) v += __shfl_xor(v, o);
    return v;
}
__device__ __forceinline__ float dot4(f32x4 v) { return (v[0] * v[0] + v[1] * v[1]) + (v[2] * v[2] + v[3] * v[3]); }
__device__ __forceinline__ float rstd4(f32x4 a) { return __builtin_amdgcn_rsqf(((a[0] + a[1]) + (a[2] + a[3])) * (1.f / DM) + EPS); }

namespace pg8 {
constexpr int BM = 256, BK = 64, HALF = 128, HTB = HALF * BK * 2, STAGE_BYTES = 8 * HTB, NXCD = 8, WGM = 8;
__host__ __device__ __forceinline__ int lds_byte(int r, int c) { const int st = (r >> 4) * 2 + (c >> 5), rr = r & 15, cc = c & 31, ob = rr * 64 + cc * 2; return st * 1024 + (ob ^ (((ob >> 9) & 1) << 5)); }
__host__ __device__ __forceinline__ void stage_rc(int b, int& R, int& C) { const int st = b / 1024, sb = b % 1024, swz = sb ^ (((sb >> 9) & 1) << 5); R = (st >> 1) * 16 + swz / 64; C = (st & 1) * 32 + (swz % 64) / 2; }
__host__ __device__ __forceinline__ int perm32(int rho) { const int n = rho >> 4, i = rho & 15; return 8 * (i >> 2) + 4 * n + (i & 3); }

struct Unit { int pm, pn; };
struct Gemm { const bf16_t* A; const bf16_t* Bt; int lda, ldb, K; long a_pm, a_pn, b_pn, b_pb; int pn_shift; long b_ph;
    __device__ __forceinline__ const char* abase(const Unit& u) const { return (const char*)A + (size_t)u.pm * a_pm + (size_t)(u.pn >> pn_shift) * a_pn; }
    __device__ __forceinline__ const char* bbase(const Unit& u) const { return (const char*)Bt + (size_t)(u.pn & ((1 << pn_shift) - 1)) * b_pn + (size_t)(u.pn >> pn_shift) * b_ph + (size_t)(u.pm >> 3) * b_pb; } };

struct StaticOrder {
    int nM, nN, nwg, G, c, rev;
    __device__ void init(int M, int N, int G_, int c_, int rev_ = 0) { nM = M / BM; nN = N / BM; nwg = nM * nN; G = G_; c = c_; rev = rev_; }
    __device__ bool next(int i, Unit& u) const {
        const long L = (long)i * G + c; if (L >= nwg) return false;
        int wgid = (int)L; { const int q = nwg / NXCD, r = nwg % NXCD, xcd = wgid % NXCD, off = wgid / NXCD; wgid = (xcd < r ? xcd * (q + 1) : r * (q + 1) + (xcd - r) * q) + off; }
        const int nig = WGM * nN, gid = wgid / nig, fm = gid * WGM, gsz = (nM - fm) < WGM ? (nM - fm) : WGM;
        u.pm = fm + ((wgid % nig) % gsz); u.pn = (wgid % nig) / gsz; if (rev) u.pm = nM - 1 - u.pm; return true;
    }
};

__device__ __forceinline__ void panel_rstd(const float* ssq, LAS unsigned char* scr, int pm, int wr, int fr, float (&rsv)[2][4]) {
    LAS float* rtab = (LAS float*)(scr + 4096); volatile LAS int* pf = (volatile LAS int*)(scr + 5120);
    if (*pf != pm) {
        asm volatile("s_waitcnt lgkmcnt(0)" ::: "memory"); __builtin_amdgcn_s_barrier(); asm volatile("" ::: "memory");
        const int t = threadIdx.x;
        if (t < BM) { rtab[t] = rstd4(*(const f32x4*)(ssq + (size_t)(pm * BM + t) * 4)); if (t == 0) *pf = pm; }
        asm volatile("s_waitcnt lgkmcnt(0)" ::: "memory"); __builtin_amdgcn_s_barrier(); asm volatile("" ::: "memory");
    }
#pragma unroll
    for (int ai = 0; ai < 2; ++ai)
#pragma unroll
        for (int m = 0; m < 4; ++m) rsv[ai][m] = rtab[ai * HALF + wr * 64 + m * 16 + fr];
}
typedef float f32x2 __attribute__((ext_vector_type(2)));
struct EpiSwiGLU {
    bf16_t* O; const float* ssq;
    __device__ __forceinline__ void operator()(const f32x4 (&acc)[2][2][4][2], const Unit& u, int wr, int wc, int fr, int fq, LAS unsigned char* scr) const {
        const int row0 = u.pm * BM + wr * 64 + fr, col0 = u.pn * HALF + wc * 32 + 8 * fq;
        float rsv[2][4]; panel_rstd(ssq, scr, u.pm, wr, fr, rsv);
#pragma unroll
        for (int ai = 0; ai < 2; ++ai)
#pragma unroll
            for (int m = 0; m < 4; ++m) {
                const int row = row0 + ai * HALF + m * 16; const float rs = rsv[ai][m], rs2 = rs * rs, ce = -rs * LOG2E; unsigned w[4];
#pragma unroll
                for (int n = 0; n < 2; ++n)
#pragma unroll
                    for (int j = 0; j < 4; j += 2) {
                        const f32x2 g = {acc[ai][0][m][n][j], acc[ai][0][m][n][j + 1]}, up = {acc[ai][1][m][n][j], acc[ai][1][m][n][j + 1]};
                        const f32x2 t = g * ce; f32x2 d; d.x = __builtin_amdgcn_exp2f(t.x); d.y = __builtin_amdgcn_exp2f(t.y); d = d + 1.0f;
                        f32x2 r; r.x = __builtin_amdgcn_rcpf(d.x); r.y = __builtin_amdgcn_rcpf(d.y);
                        const f32x2 o = (g * up) * (r * rs2); w[n * 2 + (j >> 1)] = cvt_pk_bf16(o.x, o.y); }
                *(u32x4*)(O + (size_t)row * DFF + col0) = (u32x4){w[0], w[1], w[2], w[3]}; }
    }
};
template <bool W8> struct EpiResidT {
    bf16_t* R; float* ssq; float alpha;
    __device__ __forceinline__ void operator()(const f32x4 (&acc)[2][2][4][2], const Unit& u, int wr, int wc, int fr, int fq, LAS unsigned char* scr) const {
        const int row0 = u.pm * BM + wr * 64 + fr, col0 = u.pn * BM + wc * 32 + 8 * fq;
        LAS float* tab = (LAS float*)scr;
        u32x4 bv[2][4][2];
#pragma unroll
        for (int ai = 0; ai < 2; ++ai)
#pragma unroll
            for (int m = 0; m < 4; ++m)
#pragma unroll
                for (int bj = 0; bj < 2; ++bj) bv[ai][m][bj] = *(const u32x4*)(R + (size_t)(row0 + ai * HALF + m * 16) * DM + col0 + bj * HALF);
#pragma unroll
        for (int ai = 0; ai < 2; ++ai)
#pragma unroll
            for (int m = 0; m < 4; ++m) {
                const int row = row0 + ai * HALF + m * 16; float s = 0.f;
#pragma unroll
                for (int bj = 0; bj < 2; ++bj) { const u32x4 b = bv[ai][m][bj];
                    const f32x4 b0 = {bf_lo(b.x), bf_hi(b.x), bf_lo(b.y), bf_hi(b.y)}, b1 = {bf_lo(b.z), bf_hi(b.z), bf_lo(b.w), bf_hi(b.w)};
                    const f32x4 v0 = b0 + acc[ai][bj][m][0] * alpha, v1 = b1 + acc[ai][bj][m][1] * alpha;
                    u32x4 w; w.x = cvt_pk_bf16(v0[0], v0[1]); w.y = cvt_pk_bf16(v0[2], v0[3]); w.z = cvt_pk_bf16(v1[0], v1[1]); w.w = cvt_pk_bf16(v1[2], v1[3]);
                    *(u32x4*)(R + (size_t)row * DM + col0 + bj * HALF) = w;
                    if constexpr (W8) *(u32x2*)((unsigned char*)R + X8_FROM_RB + (size_t)row * DM + col0 + bj * HALF) = (u32x2){pk4_fp8(v0[0], v0[1], v0[2], v0[3]), pk4_fp8(v1[0], v1[1], v1[2], v1[3])};
                    s += dot4(v0) + dot4(v1); }
                s += __shfl_xor(s, 16); s += __shfl_xor(s, 32); if (fq == 0) tab[(ai * HALF + wr * 64 + m * 16 + fr) * 4 + wc] = s;
            }
        asm volatile("s_waitcnt lgkmcnt(0)" ::: "memory"); __builtin_amdgcn_s_barrier(); asm volatile("" ::: "memory");
        const int t = threadIdx.x;
        if (t < BM) { const f32x4 v = *(const LAS f32x4*)(tab + t * 4); ssq[(size_t)(u.pm * BM + t) * 4 + u.pn] = (v[0] + v[1]) + (v[2] + v[3]); }
    }
};
template <bool W8, int F8S = 1> struct EpiScaleT {
    bf16_t* O; int ldc; const float* ssq; long pm_stride, pn_stride; int pn_shift; long ph_stride;
    __device__ __forceinline__ void operator()(const f32x4 (&acc)[2][2][4][2], const Unit& u, int wr, int wc, int fr, int fq, LAS unsigned char* scr) const {
        const int lr0 = wr * 64 + fr, lc0 = wc * 32 + 8 * fq;
        bf16_t* Ot = O + (size_t)u.pm * pm_stride + (size_t)(u.pn & ((1 << pn_shift) - 1)) * pn_stride + (size_t)(u.pn >> pn_shift) * ph_stride;
        float rsv[2][4];
        if (ssq) panel_rstd(ssq, scr, u.pm, wr, fr, rsv);
        else {
#pragma unroll
            for (int ai = 0; ai < 2; ++ai)
#pragma unroll
                for (int m = 0; m < 4; ++m) rsv[ai][m] = 1.0f; }
#pragma unroll
        for (int ai = 0; ai < 2; ++ai)
#pragma unroll
            for (int m = 0; m < 4; ++m) {
                const int lr = lr0 + ai * HALF + m * 16; const float rs = rsv[ai][m];
#pragma unroll
                for (int bj = 0; bj < 2; ++bj) { const f32x4 v0 = acc[ai][bj][m][0] * rs, v1 = acc[ai][bj][m][1] * rs;
                    if constexpr (W8) { const f32x4 y0 = v0 * (float)F8S, y1 = v1 * (float)F8S;
                        *(u32x2*)((unsigned char*)O + (size_t)u.pm * pm_stride + (size_t)(u.pn & ((1 << pn_shift) - 1)) * pn_stride + (size_t)(u.pn >> pn_shift) * ph_stride + (size_t)lr * ldc + lc0 + bj * HALF) =
                            (u32x2){pk4_fp8(y0[0], y0[1], y0[2], y0[3]), pk4_fp8(y1[0], y1[1], y1[2], y1[3])}; }
                    else { u32x4 w; w.x = cvt_pk_bf16(v0[0], v0[1]); w.y = cvt_pk_bf16(v0[2], v0[3]); w.z = cvt_pk_bf16(v1[0], v1[1]); w.w = cvt_pk_bf16(v1[2], v1[3]);
                        *(u32x4*)(Ot + (size_t)lr * ldc + lc0 + bj * HALF) = w; } } }
    }
};
typedef EpiResidT<false> EpiResid; typedef EpiResidT<true> EpiResid8; typedef EpiScaleT<false> EpiScale; typedef EpiScaleT<true, 64> EpiScale8K; typedef EpiScaleT<true, 4> EpiScale8V;
struct EpiSoftmax {
    unsigned char* P; const float* ssq;
    __device__ __forceinline__ void operator()(f32x4 (&acc)[2][2][4][2], const Unit& u, int wr, int wc, int fr, int fq, LAS unsigned char* scr) const {
        LAS float* tab = (LAS float*)scr;
        LAS float* tab2 = (LAS float*)(scr + 6144);
        float rsv[2][4]; panel_rstd(ssq, scr, u.pm, wr, fr, rsv);
#pragma unroll
        for (int ai = 0; ai < 2; ++ai)
#pragma unroll
            for (int m = 0; m < 4; ++m) {
                float mx = -3.0e38f; const float rs = rsv[ai][m] * (1.0f / 64.0f);
#pragma unroll
                for (int bj = 0; bj < 2; ++bj)
#pragma unroll
                    for (int n = 0; n < 2; ++n) { acc[ai][bj][m][n] = acc[ai][bj][m][n] * rs; const f32x4 x = acc[ai][bj][m][n]; mx = fmaxf(mx, fmaxf(fmaxf(x[0], x[1]), fmaxf(x[2], x[3]))); }
                mx = fmaxf(mx, __shfl_xor(mx, 16)); mx = fmaxf(mx, __shfl_xor(mx, 32));
                if (fq == 0) tab[(ai * HALF + wr * 64 + m * 16 + fr) * 4 + wc] = mx;
            }
        asm volatile("s_waitcnt lgkmcnt(0)" ::: "memory"); __builtin_amdgcn_s_barrier(); asm volatile("" ::: "memory");
#pragma unroll
        for (int ai = 0; ai < 2; ++ai)
#pragma unroll
            for (int m = 0; m < 4; ++m) {
                const int lr = ai * HALF + wr * 64 + m * 16 + fr;
                const f32x4 t = *(const LAS f32x4*)(tab + lr * 4); const float mx = fmaxf(fmaxf(t[0], t[1]), fmaxf(t[2], t[3])); float sm = 0.f;
#pragma unroll
                for (int bj = 0; bj < 2; ++bj)
#pragma unroll
                    for (int n = 0; n < 2; ++n) { f32x4 v;
#pragma unroll
                        for (int j = 0; j < 4; ++j) v[j] = __builtin_amdgcn_exp2f(acc[ai][bj][m][n][j] - mx);
                        acc[ai][bj][m][n] = v; sm += (v[0] + v[1]) + (v[2] + v[3]); }
                sm += __shfl_xor(sm, 16); sm += __shfl_xor(sm, 32); if (fq == 0) tab2[lr * 4 + wc] = sm;
            }
        asm volatile("s_waitcnt lgkmcnt(0)" ::: "memory"); __builtin_amdgcn_s_barrier(); asm volatile("" ::: "memory");
        const int row0 = u.pm * BM + wr * 64 + fr, col0 = u.pn * BM + wc * 32 + 8 * fq;
#pragma unroll
        for (int ai = 0; ai < 2; ++ai)
#pragma unroll
            for (int m = 0; m < 4; ++m) {
                const int lr = ai * HALF + wr * 64 + m * 16 + fr, row = row0 + ai * HALF + m * 16;
                const f32x4 t = *(const LAS f32x4*)(tab2 + lr * 4); const float inv = 256.0f / ((t[0] + t[1]) + (t[2] + t[3]));
#pragma unroll
                for (int bj = 0; bj < 2; ++bj) { const f32x4 v0 = acc[ai][bj][m][0] * inv, v1 = acc[ai][bj][m][1] * inv;
                    *(u32x2*)(P + (size_t)row * DM + col0 + bj * HALF) = (u32x2){pk4_fp8(v0[0], v0[1], v0[2], v0[3]), pk4_fp8(v1[0], v1[1], v1[2], v1[3])}; } }
    }
};

template <class Epi, int ESTORES = 0, bool F8 = false>
__device__ __forceinline__ void gemm_phase(LAS unsigned char* lds, LAS unsigned char* scr, const Gemm g, const StaticOrder& S, const Epi& E) {
    const int tid = threadIdx.x, wid = __builtin_amdgcn_readfirstlane(tid >> 6), lane = tid & 63, wr = wid >> 2, wc = wid & 3, fr = lane & 15, fq = lane >> 4;
    const int K = g.K, nt = K / BK;
    unsigned voffA, voffB;
    { int R, C; stage_rc(tid * 16, R, C); const int Rb = (R & ~31) + perm32(R & 31); voffA = (unsigned)(R * g.lda + C) * 2u; voffB = (unsigned)(Rb * g.ldb + C) * 2u; }
    const size_t dA = (size_t)64 * g.lda * 2, dB = (size_t)64 * g.ldb * 2;
    const size_t kstep = (size_t)(BK * 2);
    const size_t hstepA = (size_t)HALF * g.lda * 2, hstepB = (size_t)HALF * g.ldb * 2;
    const unsigned ldsw = (unsigned)wid * 1024u; const unsigned ldsbase = (unsigned)(size_t)lds;
    const int aoff = lds_byte(wr * 64 + fr, fq * 8), boff = lds_byte(wc * 32 + fr, fq * 8);
#define PG8_SA(b, h) (((b) * 2 + (h)) * HTB)
#define PG8_SB(b, h) ((4 + (b) * 2 + (h)) * HTB)
#define PG8_STAGE(bufoff, gbase, voff, dlt) do { _Pragma("unroll") for (int _i = 0; _i < 2; ++_i) { unsigned _keep; \
        asm volatile("s_mov_b32 %0, m0\n\ts_mov_b32 m0, %3\n\ts_nop 0\n\tglobal_load_lds_dwordx4 %1, %2\n\ts_mov_b32 m0, %0" \
            : "=&s"(_keep) : "v"(voff), "s"((const char*)(gbase) + _i * (dlt)), "s"((unsigned)(ldsbase + (bufoff) + ldsw + _i * 8192)) : "memory"); } } while (0)
#define PG8_LDA(dst, b, h) do { _Pragma("unroll") for (int m = 0; m < 4; ++m) _Pragma("unroll") for (int k = 0; k < 2; ++k) dst[m][k] = *(const LAS bf16x8*)(lds + PG8_SA(b, h) + aoff + m * 2048 + k * 1024); } while (0)
#define PG8_LDB(dst, b, h) do { _Pragma("unroll") for (int n = 0; n < 2; ++n) _Pragma("unroll") for (int k = 0; k < 2; ++k) dst[n][k] = *(const LAS bf16x8*)(lds + PG8_SB(b, h) + boff + n * 2048 + k * 1024); } while (0)
#define PG8_CAT(x) __builtin_bit_cast(v8i32, __builtin_shufflevector(x[0], x[1], 0, 1, 2, 3, 4, 5, 6, 7, 8, 9, 10, 11, 12, 13, 14, 15))
#define PG8_MMA(ai, bj, At, Bt) do { __builtin_amdgcn_s_setprio(1); _Pragma("unroll") for (int m = 0; m < 4; ++m) _Pragma("unroll") for (int n = 0; n < 2; ++n) { \
        if constexpr (F8) acc[ai][bj][m][n] = __builtin_amdgcn_mfma_scale_f32_16x16x128_f8f6f4(PG8_CAT(Bt[n]), PG8_CAT(At[m]), acc[ai][bj][m][n], 0, 0, 0, 0x7f7f7f7f, 0, 0x7f7f7f7f); \
        else { _Pragma("unroll") for (int k = 0; k < 2; ++k) acc[ai][bj][m][n] = __builtin_amdgcn_mfma_f32_16x16x32_bf16(Bt[n][k], At[m][k], acc[ai][bj][m][n], 0, 0, 0); } } \
        __builtin_amdgcn_s_setprio(0); } while (0)
#define PG8_WAIT_V(n) asm volatile("s_waitcnt vmcnt(" #n ")" ::: "memory")
#define PG8_WAIT_L(n) asm volatile("s_waitcnt lgkmcnt(" #n ")" ::: "memory")
#define PG8_BAR __builtin_amdgcn_s_barrier()
#define PG8_SCHED __builtin_amdgcn_sched_barrier(0)
    Unit cur, nxt; int ui = 0;
    if (!S.next(0, cur)) return;
    if (tid == 0) *(volatile LAS int*)(scr + 5120) = -1;
    f32x4 acc[2][2][4][2];
#pragma unroll
    for (int a = 0; a < 2; ++a)
#pragma unroll
        for (int b = 0; b < 2; ++b)
#pragma unroll
            for (int m = 0; m < 4; ++m)
#pragma unroll
                for (int n = 0; n < 2; ++n) acc[a][b][m][n] = (f32x4){0.f, 0.f, 0.f, 0.f};
    bf16x8 At[4][2], B0[2][2], B1[2][2];
    const char* cA = g.abase(cur);
    const char* cB = g.bbase(cur);
    PG8_STAGE(PG8_SB(0, 0), cB, voffB, dB); PG8_STAGE(PG8_SB(0, 1), cB + hstepB, voffB, dB); PG8_STAGE(PG8_SA(0, 0), cA, voffA, dA); PG8_STAGE(PG8_SA(0, 1), cA + hstepA, voffA, dA);
    if (wr == 1) PG8_BAR;
    PG8_WAIT_V(2); PG8_BAR;
    PG8_STAGE(PG8_SB(1, 0), cB + kstep, voffB, dB); PG8_STAGE(PG8_SA(1, 0), cA + kstep, voffA, dA); PG8_STAGE(PG8_SB(1, 1), cB + hstepB + kstep, voffB, dB);
    PG8_WAIT_V(6); PG8_BAR;
    for (;;) {
        const bool has_next = S.next(ui + 1, nxt);
        const char* nA = has_next ? g.abase(nxt) : cA;
        const char* nB = has_next ? g.bbase(nxt) : cB;
#define PG8_TRIP(W) do { \
            const bool last = (t == nt - 2); \
            const char* a1 = cA + (size_t)(t + 1) * kstep; \
            const char* a2 = last ? nA : cA + (size_t)(t + 2) * kstep; const char* b2 = last ? nB : cB + (size_t)(t + 2) * kstep; \
            const char* a3 = a2 + kstep; const char* b3 = b2 + kstep; \
            PG8_LDB(B0, 0, 0); PG8_LDB(B1, 0, 1); PG8_SCHED; PG8_LDA(At, 0, 0); PG8_STAGE(PG8_SA(1, 1), a1 + hstepA, voffA, dA); \
            PG8_WAIT_V(W); PG8_WAIT_L(0); PG8_BAR; PG8_MMA(0, 0, At, B0); PG8_MMA(0, 1, At, B1); PG8_BAR; PG8_SCHED; \
            PG8_LDA(At, 0, 1); PG8_STAGE(PG8_SB(0, 0), b2, voffB, dB); PG8_STAGE(PG8_SB(0, 1), b2 + hstepB, voffB, dB); PG8_STAGE(PG8_SA(0, 0), a2, voffA, dA); \
            PG8_WAIT_V(W); PG8_WAIT_L(0); PG8_BAR; PG8_MMA(1, 0, At, B0); PG8_MMA(1, 1, At, B1); PG8_BAR; PG8_SCHED; \
            PG8_LDB(B0, 1, 0); PG8_LDB(B1, 1, 1); PG8_SCHED; PG8_LDA(At, 1, 0); PG8_STAGE(PG8_SA(0, 1), a2 + hstepA, voffA, dA); \
            PG8_WAIT_V(8); PG8_WAIT_L(0); PG8_BAR; PG8_MMA(0, 0, At, B0); PG8_MMA(0, 1, At, B1); PG8_BAR; PG8_SCHED; \
            PG8_LDA(At, 1, 1); PG8_STAGE(PG8_SB(1, 0), b3, voffB, dB); PG8_STAGE(PG8_SB(1, 1), b3 + hstepB, voffB, dB); PG8_STAGE(PG8_SA(1, 0), a3, voffA, dA); \
            PG8_WAIT_V(8); PG8_WAIT_L(0); PG8_BAR; PG8_MMA(1, 0, At, B0); PG8_MMA(1, 1, At, B1); PG8_BAR; PG8_SCHED; } while (0)
        int t = 0;
        if (ESTORES > 0 && ui > 0) { if constexpr (ESTORES == 8) PG8_TRIP(16); else if constexpr (ESTORES == 16) PG8_TRIP(24); else if constexpr (ESTORES == 32) PG8_TRIP(40); t = 2; }
        for (; t < nt; t += 2) PG8_TRIP(8);
#undef PG8_TRIP
        if (wr == 0) PG8_BAR;
        { int fr_o = fr, fq_o = fq; asm volatile("" : "+v"(fr_o), "+v"(fq_o));
          E(acc, cur, wr, wc, fr_o, fq_o, scr); }
        if (!has_next) break;
#pragma unroll
        for (int a = 0; a < 2; ++a)
#pragma unroll
            for (int b = 0; b < 2; ++b)
#pragma unroll
                for (int m = 0; m < 4; ++m)
#pragma unroll
                    for (int n = 0; n < 2; ++n) acc[a][b][m][n] = (f32x4){0.f, 0.f, 0.f, 0.f};
        cur = nxt; cA = nA; cB = nB; ++ui;
        if (wr == 1) PG8_BAR;
    }
    PG8_WAIT_V(0);
    PG8_BAR;
#undef PG8_SA
#undef PG8_SB
#undef PG8_STAGE
#undef PG8_LDA
#undef PG8_LDB
#undef PG8_MMA
#undef PG8_CAT
#undef PG8_WAIT_V
#undef PG8_WAIT_L
#undef PG8_BAR
#undef PG8_SCHED
}
}

namespace sb {
constexpr int PITCH = INC;
constexpr int SLOTB = 8192, LDS_K = 0, LDS_V = 2 * SLOTB, LDS_FLAG = 4 * SLOTB, LDS_OST = LDS_FLAG + 256, LDS_BYTES = LDS_OST + 8 * 4096;
constexpr float DONE_THR = -150.0f;
typedef LAS const char* lds_cptr;
typedef short v4i16_t __attribute__((ext_vector_type(4)));
__device__ __forceinline__ int crow(int r, int hi) { return (r & 3) + 8 * (r >> 2) + 4 * hi; }
__device__ __forceinline__ void glds16(const void* gsrc, unsigned lds_dst) { unsigned keep;
    asm volatile("s_mov_b32 %0, m0\n\ts_mov_b32 m0, %2\n\ts_nop 0\n\tglobal_load_lds_dwordx4 %1, off\n\ts_mov_b32 m0, %0" : "=&s"(keep) : "v"(gsrc), "s"(lds_dst) : "memory"); }
__device__ __forceinline__ s16x4 vtr(lds_cptr p) { return __builtin_bit_cast(s16x4, __builtin_amdgcn_ds_read_tr16_b64_v4i16((LAS v4i16_t*)p)); }
__device__ __forceinline__ float xhalf(float v, int hi) {
    auto rr = __builtin_amdgcn_permlane32_swap(__float_as_uint(v), __float_as_uint(v), false, false);
    return __uint_as_float(hi ? rr[0] : rr[1]);
}
#define SB_WAIT_BAR(N) asm volatile("s_waitcnt vmcnt(" #N ") lgkmcnt(0)\n\ts_barrier" ::: "memory")

__device__ __forceinline__ void sb_tile(lds_cptr kp, lds_cptr vp, const bf16x8 (&qr)[4], f32x16 (&o)[2], float& carry, bool& wdone, bool diag, int kb, int tq, int hi, int ksw) {
    f32x16 p0 = f32x16{}, p1 = f32x16{};
#pragma unroll
    for (int d0 = 0; d0 < 4; ++d0) {
        const int ko = ((2 * d0 + hi) ^ ksw) * 16;
        const bf16x8 b0 = *(const LAS bf16x8*)(kp + ko), b1 = *(const LAS bf16x8*)(kp + ko + 4096);
        p0 = __builtin_amdgcn_mfma_f32_32x32x16_bf16(b0, qr[d0], p0, 0, 0, 0);
        p1 = __builtin_amdgcn_mfma_f32_32x32x16_bf16(b1, qr[d0], p1, 0, 0, 0); }
    f32x16 l0, l1;
#pragma unroll
    for (int r = 0; r < 16; ++r) {
        { const float z = fminf(p0[r], 126.f); const float L2 = __builtin_amdgcn_logf(1.0f + __builtin_amdgcn_exp2f(z)); l0[r] = -L2; p0[r] = z - L2; }
        { const float z = fminf(p1[r], 126.f); const float L2 = __builtin_amdgcn_logf(1.0f + __builtin_amdgcn_exp2f(z)); l1[r] = -L2; p1[r] = z - L2; }
    }
    if (diag) {
#pragma unroll
        for (int r = 0; r < 16; ++r) { const int kv = kb + (r & 3) + 8 * (r >> 2);
            if (kv >= tq) { l0[r] = 0.f; p0[r] = -1.0e30f; }
            if (kv + 32 >= tq) { l1[r] = 0.f; p1[r] = -1.0e30f; } }
    }
    float gs[8], ps[8];
#pragma unroll
    for (int g = 0; g < 4; ++g) { gs[g] = (l0[4 * g] + l0[4 * g + 1]) + (l0[4 * g + 2] + l0[4 * g + 3]); gs[4 + g] = (l1[4 * g] + l1[4 * g + 1]) + (l1[4 * g + 2] + l1[4 * g + 3]); }
#pragma unroll
    for (int g = 0; g < 8; ++g) ps[g] = xhalf(gs[g], hi);
    float run = carry;
#pragma unroll
    for (int g = 7; g >= 0; --g) {
        const float base = run + (hi ? 0.f : ps[g]);
        if (g >= 4) { const int q = 4 * (g - 4);
            const float e3 = base, e2 = e3 + l1[q + 3], e1 = e2 + l1[q + 2], e0 = e1 + l1[q + 1];
            p1[q + 3] = __builtin_amdgcn_exp2f(p1[q + 3] + e3); p1[q + 2] = __builtin_amdgcn_exp2f(p1[q + 2] + e2);
            p1[q + 1] = __builtin_amdgcn_exp2f(p1[q + 1] + e1); p1[q] = __builtin_amdgcn_exp2f(p1[q] + e0);
        } else { const int q = 4 * g;
            const float e3 = base, e2 = e3 + l0[q + 3], e1 = e2 + l0[q + 2], e0 = e1 + l0[q + 1];
            p0[q + 3] = __builtin_amdgcn_exp2f(p0[q + 3] + e3); p0[q + 2] = __builtin_amdgcn_exp2f(p0[q + 2] + e2);
            p0[q + 1] = __builtin_amdgcn_exp2f(p0[q + 1] + e1); p0[q] = __builtin_amdgcn_exp2f(p0[q] + e0);
        }
        run += gs[g] + ps[g];
    }
    carry = run;
    wdone = __all(carry < DONE_THR);
    u32x4 pw0, pw1, pw2, pw3;
    pw0 = (u32x4){cvt_pk_bf16(p0[0], p0[1]), cvt_pk_bf16(p0[2], p0[3]), cvt_pk_bf16(p0[4], p0[5]), cvt_pk_bf16(p0[6], p0[7])};
    pw1 = (u32x4){cvt_pk_bf16(p0[8], p0[9]), cvt_pk_bf16(p0[10], p0[11]), cvt_pk_bf16(p0[12], p0[13]), cvt_pk_bf16(p0[14], p0[15])};
    pw2 = (u32x4){cvt_pk_bf16(p1[0], p1[1]), cvt_pk_bf16(p1[2], p1[3]), cvt_pk_bf16(p1[4], p1[5]), cvt_pk_bf16(p1[6], p1[7])};
    pw3 = (u32x4){cvt_pk_bf16(p1[8], p1[9]), cvt_pk_bf16(p1[10], p1[11]), cvt_pk_bf16(p1[12], p1[13]), cvt_pk_bf16(p1[14], p1[15])};
#define SB_VFR(lo, hi_) (bf16x8){lo[0], lo[1], lo[2], lo[3], hi_[0], hi_[1], hi_[2], hi_[3]}
#pragma unroll
    for (int d0 = 0; d0 < 2; ++d0) {
        s16x4 vlo[4], vhi[4];
#pragma unroll
        for (int ks = 0; ks < 4; ++ks) { vlo[ks] = vtr(vp + d0 * 4096 + ks * 1024); vhi[ks] = vtr(vp + d0 * 4096 + ks * 1024 + 512); }
        o[d0] = __builtin_amdgcn_mfma_f32_32x32x16_bf16(__builtin_bit_cast(bf16x8, pw0), SB_VFR(vlo[0], vhi[0]), o[d0], 0, 0, 0);
        o[d0] = __builtin_amdgcn_mfma_f32_32x32x16_bf16(__builtin_bit_cast(bf16x8, pw1), SB_VFR(vlo[1], vhi[1]), o[d0], 0, 0, 0);
        o[d0] = __builtin_amdgcn_mfma_f32_32x32x16_bf16(__builtin_bit_cast(bf16x8, pw2), SB_VFR(vlo[2], vhi[2]), o[d0], 0, 0, 0);
        o[d0] = __builtin_amdgcn_mfma_f32_32x32x16_bf16(__builtin_bit_cast(bf16x8, pw3), SB_VFR(vlo[3], vhi[3]), o[d0], 0, 0, 0);
    }
#undef SB_VFR
}

constexpr int STG = 65536, V_OFF = 32768;
__device__ __forceinline__ void sb_unit8(int b, int hg, int qb2, const bf16_t* proj, bf16_t* mix, char* shm, volatile LAS unsigned* flag) {
    const int tid = threadIdx.x, lane = tid & 63, r32 = lane & 31, hi = lane >> 5; const int wid = __builtin_amdgcn_readfirstlane(tid >> 6);
    const int hh = wid >> 1, h = hg * 4 + hh, sub = wid & 1;
    const long rowbase = (long)b * SEQ; const int q0 = qb2 * 128;
    const unsigned lds0 = (unsigned)(uintptr_t)shm;
    const int krow = 8 * wid + (lane >> 3);
    const bf16_t* ksrc = proj + rowbase * PITCH + 512 + hg * 256 + (long)krow * PITCH + (((lane & 7) ^ ((krow >> 1) & 7)) * 8);
    const bf16_t* vsrc = proj + rowbase * PITCH + 1024 + hg * 256 + (long)(16 * (wid & 3) + (lane >> 2)) * PITCH + (wid >> 2) * 32 + (lane & 3) * 8;
    const unsigned kdst = lds0 + wid * 1024, vdst = lds0 + V_OFF + wid * 1024;
#define DMA_KV(t, stg) do { _Pragma("unroll") for (int x_ = 0; x_ < 4; ++x_) { \
        glds16(ksrc + x_ * 64 + (long)(t) * 64 * PITCH, (unsigned)__builtin_amdgcn_readfirstlane(kdst + (stg) + x_ * 8192)); \
        glds16(vsrc + x_ * 64 + (long)(t) * 64 * PITCH, (unsigned)__builtin_amdgcn_readfirstlane(vdst + (stg) + x_ * 8192)); } } while (0)
    const lds_cptr shm3 = (lds_cptr)shm;
    const lds_cptr kp0 = shm3 + hh * 8192 + r32 * 128; const int ksw = (r32 >> 1) & 7;
    const lds_cptr vp0 = shm3 + V_OFF + hh * 8192 + ((lane >> 4) & 1) * 32 + (lane & 3) * 8 + (4 * hi + ((lane & 15) >> 2)) * 64;
    const int jtop = 2 * qb2 + 1;
    DMA_KV(jtop, 0);
    bf16x8 qa[4], qb[4];
    {   const bf16_t* Qa = proj + (rowbase + q0 + 64 + sub * 32) * PITCH + h * 64; const bf16_t* Qb = proj + (rowbase + q0 + sub * 32) * PITCH + h * 64;
#pragma unroll
        for (int d0 = 0; d0 < 4; ++d0) { qa[d0] = *reinterpret_cast<const bf16x8*>(&Qa[(long)r32 * PITCH + d0 * 16 + hi * 8]); qb[d0] = *reinterpret_cast<const bf16x8*>(&Qb[(long)r32 * PITCH + d0 * 16 + hi * 8]); } }
    asm volatile("" : "+v"(qa[0]), "+v"(qa[1]), "+v"(qa[2]), "+v"(qa[3]), "+v"(qb[0]), "+v"(qb[1]), "+v"(qb[2]), "+v"(qb[3]));
    f32x16 oa[2], ob[2]; oa[0] = f32x16{}; oa[1] = f32x16{}; ob[0] = f32x16{}; ob[1] = f32x16{};
    float ca = 0.f, cb = 0.f; bool da = false, db = false;
    const int tqa = q0 + 64 + sub * 32 + r32, tqb = q0 + sub * 32 + r32;
    int stage = 0;
    for (int it = 0, j = jtop;; ++it, --j) {
        stage = (it & 1) * STG; const int nstage = STG - stage;
        if (j > 0) { DMA_KV(j - 1, nstage); SB_WAIT_BAR(8); } else { SB_WAIT_BAR(0); }
        const int kb = 64 * j + 4 * hi;
        if (!da) sb_tile(kp0 + stage, vp0 + stage, qa, oa, ca, da, j == jtop, kb, tqa, hi, ksw);
        if (!db && j < jtop) sb_tile(kp0 + stage, vp0 + stage, qb, ob, cb, db, j == jtop - 1, kb, tqb, hi, ksw);
        if (lane == 0) flag[wid] = (da && db) ? 1u : 0u;
        asm volatile("s_waitcnt lgkmcnt(0)\n\ts_barrier" ::: "memory");
        unsigned alld = 1u;
#pragma unroll
        for (int w = 0; w < 8; ++w) alld &= flag[w];
        if (alld || j == 0) break;
    }
    {   bf16_t* stg = (bf16_t*)(shm + stage) + wid * 4096;
#pragma unroll
        for (int r = 0; r < 16; ++r) { const int orow = crow(r, hi);
#pragma unroll
            for (int d0 = 0; d0 < 2; ++d0) { stg[orow * 64 + d0 * 32 + r32] = (bf16_t)(cvt_pk_bf16(oa[d0][r], 0.f) & 0xffffu); stg[2048 + orow * 64 + d0 * 32 + r32] = (bf16_t)(cvt_pk_bf16(ob[d0][r], 0.f) & 0xffffu); } }
        asm volatile("s_waitcnt lgkmcnt(0)" ::: "memory");
        bf16_t* Oa = mix + (rowbase + q0 + 64 + sub * 32) * DM + h * 64; bf16_t* Ob = mix + (rowbase + q0 + sub * 32) * DM + h * 64;
#pragma unroll
        for (int i = 0; i < 4; ++i) { const int row = i * 8 + (lane >> 3), ch = lane & 7;
            const u32x4 va = *(const u32x4*)(stg + row * 64 + ch * 8), vb = *(const u32x4*)(stg + 2048 + row * 64 + ch * 8);
            *(u32x4*)(Oa + (long)row * DM + ch * 8) = va; *(u32x4*)(Ob + (long)row * DM + ch * 8) = vb; } }
    asm volatile("s_waitcnt vmcnt(0) lgkmcnt(0)\n\ts_barrier" ::: "memory");
#undef DMA_KV
}
#undef SB_WAIT_BAR
}

#define XB_TMO      128
#define XB_XCNT(j)  (256  + 64 * (j))
#define XB_XSUB(j)  (1280 + 64 * (j))
#define XB_XGEN(j)  (2304 + 64 * (j))
#define XB_TOP      3328
#define XB_TOPGEN   3392
#define XCD_BAR_WORDS 3456
#define XB_SPIN_CAP (1u << 18)
__device__ __forceinline__ unsigned xb_ld(unsigned* p)              { return __hip_atomic_load(p, __ATOMIC_RELAXED, __HIP_MEMORY_SCOPE_AGENT); }
__device__ __forceinline__ unsigned xb_add(unsigned* p, unsigned v) { return __hip_atomic_fetch_add(p, v, __ATOMIC_RELAXED, __HIP_MEMORY_SCOPE_AGENT); }
__device__ __forceinline__ unsigned xb_xcc_id() { return (unsigned)__builtin_amdgcn_s_getreg((3 << 11) | 20) & 0xFu; }
#define XB_SPIN(cond, bar) do { unsigned _sp = 0; while (cond) { __builtin_amdgcn_s_sleep(1); \
    if ((++_sp & 255u) == 0u) { if (xb_ld(&(bar)[XB_TMO])) break; if (_sp > XB_SPIN_CAP) { atomicAdd(&(bar)[XB_TMO], 1u); break; } } } } while (0)
struct XcdBarrier { unsigned* bar; unsigned x; volatile LAS unsigned* st; };
__device__ __forceinline__ XcdBarrier xcd_barrier_post(unsigned* bar, volatile LAS unsigned* st) {
    XcdBarrier b; b.bar = bar; b.x = xb_xcc_id(); b.st = st;
    if (threadIdx.x == 0) (void)xb_add(&bar[XB_XCNT(b.x)], 1u);
    return b;
}
__device__ __forceinline__ void xcd_barrier_complete(unsigned* bar, unsigned x, unsigned& nloc, unsigned& nx) {
    const unsigned G = gridDim.x * gridDim.y * gridDim.z;
    unsigned sum, cnt, mine, sp = 0u;
    for (;;) {
        sum = 0u; cnt = 0u; mine = 0u;
#pragma unroll
        for (unsigned j = 0; j < 16; ++j) { const unsigned c = xb_ld(&bar[XB_XCNT(j)]); sum += c; cnt += (c > 0u) ? 1u : 0u; mine = (j == x) ? c : mine; }
        if (sum == G) break;
        __builtin_amdgcn_s_sleep(1);
        if ((++sp & 255u) == 0u) { if (xb_ld(&bar[XB_TMO])) break; if (sp > XB_SPIN_CAP) { atomicAdd(&bar[XB_TMO], 1u); break; } }
    }
    nloc = mine > 0u ? mine : 1u; nx = cnt > 0u ? cnt : 1u;
}
__device__ __forceinline__ void xcd_barrier(const XcdBarrier& b) {
    asm volatile("s_waitcnt vmcnt(0)" ::: "memory");
    __syncthreads();
    if (threadIdx.x == 0) {
        unsigned* bar = b.bar;
        __builtin_amdgcn_s_waitcnt(0);
        unsigned nloc = b.st[0], nx = b.st[1];
        if (nloc == 0u) { xcd_barrier_complete(bar, b.x, nloc, nx); b.st[0] = nloc; b.st[1] = nx; }
        const unsigned old = xb_add(&bar[XB_XSUB(b.x)], 1u);
        const unsigned gen = old / nloc;
        if (old + 1u == (gen + 1u) * nloc) {
            __builtin_amdgcn_fence(__ATOMIC_RELEASE, "agent");
            asm volatile("s_waitcnt vmcnt(0)" ::: "memory");
            const unsigned og = xb_add(&bar[XB_TOP], 1u);
            const unsigned tg = og / nx;
            if (og + 1u == (tg + 1u) * nx) xb_add(&bar[XB_TOPGEN], 1u);
            else XB_SPIN(xb_ld(&bar[XB_TOPGEN]) == tg, bar);
            __builtin_amdgcn_fence(__ATOMIC_ACQUIRE, "agent");
            xb_add(&bar[XB_XGEN(b.x)], 1u);
            asm volatile("s_waitcnt vmcnt(0)" ::: "memory");
        } else {
            XB_SPIN(xb_ld(&bar[XB_XGEN(b.x)]) == gen, bar);
            __builtin_amdgcn_fence(__ATOMIC_ACQUIRE, "agent");
            asm volatile("s_waitcnt vmcnt(0)" ::: "memory");
        }
    }
    __syncthreads();
}

constexpr size_t MiB = 1u << 20;
constexpr size_t WS_WGU1 = 1 * MiB, WS_WD1 = 12 * MiB, WS_WIN = 18 * MiB, WS_WOUT = 22 * MiB, WS_WQ = 24 * MiB, WS_WKV = 26 * MiB, WS_WO = 30 * MiB,
                 WS_WGU2 = 32 * MiB, WS_WD2 = 43 * MiB;
constexpr size_t WS_SSQ = 50 * MiB, WS_LSUM = 54 * MiB;
constexpr size_t WS_MEMN = 58 * MiB, WS_KM = 74 * MiB, WS_VT = 90 * MiB;
constexpr size_t WS_RB = 106 * MiB;
constexpr size_t WS_BIG = 234 * MiB;
constexpr size_t WS_PROJ = WS_BIG, WS_MIX = WS_BIG + 256 * MiB, WS_QM = WS_BIG, WS_PS = WS_BIG + 128 * MiB, WS_OM = WS_MIX;
constexpr size_t WS_KQT = WS_BIG + 384 * MiB, WS_VWOT = WS_KQT + 64 * MiB;
constexpr size_t WS_END = WS_VWOT + 64 * MiB;
static_assert(WS_WGU1 + (size_t)2 * DFF * DM * 2 <= WS_WD1 && WS_WD1 + (size_t)DM * DFF * 2 <= WS_WIN && WS_WGU2 + (size_t)2 * DFF * DM * 2 <= WS_WD2 && WS_WD2 + (size_t)DM * DFF * 2 <= WS_SSQ, "ws map");
static_assert((size_t)T * DFF * 2 <= 384 * MiB, "act fits");
static_assert((long)(WS_PS + 64 * MiB) - (long)WS_RB == X8_FROM_RB, "X8_FROM_RB");

constexpr int RING_BYTES = 131072, SCR_OFF = RING_BYTES, XBST_OFF = 143360, LDS_BYTES = 147456;
constexpr int NPHASE = 11;
constexpr float F8_SK = 64.0f, F8_SV = 4.0f;

struct Args { const float* in[21]; float* out; unsigned char* ws; int ph_lo, ph_hi; };

template <int W> __device__ __forceinline__ void pool_item(const bf16_t* __restrict__ y, bf16_t* __restrict__ o, int pos0) {
    u32x4 R[W - 1 + 16];
#pragma unroll
    for (int i = 0; i < W - 1; ++i) { const int d = W - 1 - i; R[i] = (pos0 - d >= 0) ? *(const u32x4*)(y - (ptrdiff_t)d * INC) : (u32x4){0u, 0u, 0u, 0u}; }
#pragma unroll
    for (int tt = 0; tt < 16; ++tt) R[W - 1 + tt] = *(const u32x4*)(y + (size_t)tt * INC);
    float sum[8];
#pragma unroll
    for (int e = 0; e < 8; ++e) sum[e] = 0.f;
#pragma unroll
    for (int i = 0; i < W - 1; ++i) { const u32x4 v = R[i];
        sum[0] += bf_lo(v.x); sum[1] += bf_hi(v.x); sum[2] += bf_lo(v.y); sum[3] += bf_hi(v.y); sum[4] += bf_lo(v.z); sum[5] += bf_hi(v.z); sum[6] += bf_lo(v.w); sum[7] += bf_hi(v.w); }
#pragma unroll
    for (int tt = 0; tt < 16; ++tt) { const u32x4 v = R[W - 1 + tt];
        const float cur[8] = {bf_lo(v.x), bf_hi(v.x), bf_lo(v.y), bf_hi(v.y), bf_lo(v.z), bf_hi(v.z), bf_lo(v.w), bf_hi(v.w)};
        const int pos = pos0 + tt; const float inv = 1.0f / (float)(pos + 1 < W ? pos + 1 : W); float r[8];
#pragma unroll
        for (int e = 0; e < 8; ++e) { sum[e] += cur[e]; r[e] = sum[e] * inv - cur[e]; }
        u32x4 wv; wv.x = cvt_pk_bf16(r[0], r[1]); wv.y = cvt_pk_bf16(r[2], r[3]); wv.z = cvt_pk_bf16(r[4], r[5]); wv.w = cvt_pk_bf16(r[6], r[7]);
        *(u32x4*)(o + (size_t)tt * DM) = wv;
        const u32x4 q = R[tt];
        sum[0] -= bf_lo(q.x); sum[1] -= bf_hi(q.x); sum[2] -= bf_lo(q.y); sum[3] -= bf_hi(q.y); sum[4] -= bf_lo(q.z); sum[5] -= bf_hi(q.z); sum[6] -= bf_lo(q.w); sum[7] -= bf_hi(q.w); }
}

__device__ __forceinline__ void p0_transpose_item(const float* W, int ldw, int colsrc, int K, const float* gain, float scale, bf16_t* WT, int drow0, int k0, LAS float* scr, int lane) {
    float wv[32];
#pragma unroll
    for (int i = 0; i < 32; ++i) { const int kk = 2 * i + (lane >> 5); wv[i] = __builtin_nontemporal_load(W + (size_t)(k0 + kk) * ldw + colsrc + (lane & 31)); }
#pragma unroll
    for (int i = 0; i < 32; ++i) { const int kk = 2 * i + (lane >> 5); const float gk = gain ? gain[k0 + kk] * scale : scale;
        scr[kk * 33 + (lane & 31)] = wv[i] * gk; }
    asm volatile("s_waitcnt lgkmcnt(0)" ::: "memory");
    const int c = lane & 7;
#pragma unroll
    for (int j = 0; j < 4; ++j) { const int n = (lane >> 3) + 8 * j; const LAS float* s = scr + (8 * c) * 33 + n;
        u32x4 o; o.x = cvt_pk_bf16(s[0 * 33], s[1 * 33]); o.y = cvt_pk_bf16(s[2 * 33], s[3 * 33]); o.z = cvt_pk_bf16(s[4 * 33], s[5 * 33]); o.w = cvt_pk_bf16(s[6 * 33], s[7 * 33]);
        *(u32x4*)(WT + (size_t)(drow0 + n) * K + k0 + 8 * c) = o; }
    asm volatile("s_waitcnt lgkmcnt(0)" ::: "memory");
}

__global__ void __launch_bounds__(512, 2) fwd_megakernel(Args args) {
    extern __shared__ __attribute__((aligned(16))) unsigned char lds[];
    LAS unsigned char* ldsl = (LAS unsigned char*)lds;
    const int tid = threadIdx.x, lane = tid & 63, wave = __builtin_amdgcn_readfirstlane(tid >> 6);
    const int G = gridDim.x, bx = blockIdx.x;
    const int gw = bx * 8 + wave, NGW = G * 8;
    unsigned char* ws = args.ws;
    const float* x = args.in[0]; const float* mem = args.in[1];
    float* out = args.out;
    bf16_t* Wgu1 = (bf16_t*)(ws + WS_WGU1); bf16_t* Wd1 = (bf16_t*)(ws + WS_WD1); bf16_t* Win = (bf16_t*)(ws + WS_WIN); bf16_t* Wout = (bf16_t*)(ws + WS_WOUT);
    bf16_t* Wq = (bf16_t*)(ws + WS_WQ); bf16_t* Wkv = (bf16_t*)(ws + WS_WKV); bf16_t* Wo = (bf16_t*)(ws + WS_WO); bf16_t* Wgu2 = (bf16_t*)(ws + WS_WGU2); bf16_t* Wd2 = (bf16_t*)(ws + WS_WD2);
    float* ssq = (float*)(ws + WS_SSQ);
    bf16_t* memn = (bf16_t*)(ws + WS_MEMN); bf16_t* KV = (bf16_t*)(ws + WS_KM);
    bf16_t* KqT = (bf16_t*)(ws + WS_KQT); bf16_t* VWoT = (bf16_t*)(ws + WS_VWOT);
    bf16_t* Rb = (bf16_t*)(ws + WS_RB); bf16_t* act = (bf16_t*)(ws + WS_BIG); bf16_t* proj = (bf16_t*)(ws + WS_PROJ); bf16_t* mix = (bf16_t*)(ws + WS_MIX);
    unsigned char* Ps8 = ws + WS_PS; unsigned char* X8 = ws + WS_PS + 64 * MiB; (void)F8_SK;
    const int lo = args.ph_lo, hi = args.ph_hi;
    cg::grid_group grid = cg::this_grid();
#define IN(k) (lo <= (k) && (k) < hi)
    unsigned* barw = (unsigned*)ws;
    unsigned* readyw = barw + 4096;
    constexpr unsigned READY_MAGIC = 0x600DF00Du;
    volatile LAS unsigned* xbst = (volatile LAS unsigned*)(ldsl + XBST_OFF);
    if (tid < 4) xbst[tid] = 0u;
    __syncthreads();
    if (lo < 0) grid.sync();
    if (bx == 0) {
        for (int i = tid; i < XCD_BAR_WORDS; i += 512) barw[i] = 0u;
        __threadfence(); __syncthreads();
        if (tid == 0) { __builtin_amdgcn_fence(__ATOMIC_RELEASE, "agent"); asm volatile("s_waitcnt vmcnt(0)" ::: "memory"); __hip_atomic_store(readyw, READY_MAGIC, __ATOMIC_RELAXED, __HIP_MEMORY_SCOPE_AGENT); }
    }
    XcdBarrier xbar; xbar.bar = barw; xbar.x = 0; xbar.st = xbst;
#define SEAM(k) do { if (IN(k) && IN((k) + 1)) { if ((k) == 0) { \
        if (tid == 0) { unsigned sp_ = 0; while (__hip_atomic_load(readyw, __ATOMIC_RELAXED, __HIP_MEMORY_SCOPE_AGENT) != READY_MAGIC) { __builtin_amdgcn_s_sleep(1); if (++sp_ > (1u << 22)) break; } \
            __builtin_amdgcn_fence(__ATOMIC_ACQUIRE, "agent"); asm volatile("s_waitcnt vmcnt(0)" ::: "memory"); } \
        __syncthreads(); xbar = xcd_barrier_post(barw, xbst); } \
        xcd_barrier(xbar); } } while (0)
#ifndef PROBE_DUP
#define PROBE_DUP 0
#endif
#define REP(k) for (int rep_ = 0; rep_ < 1 + ((PROBE_DUP >> (k)) & 1); ++rep_)

    if (IN(0)) REP(0) {
        LAS float* scr = (LAS float*)(ldsl + wave * 16384);
        constexpr int I_G = (DM / 64) * (DFF / 32), I_D = (DFF / 64) * (DM / 32), I_INQ = 16 * 16, I_INKV = 16 * 32, I_SQ = 16 * 32, I_KV = 16 * 64;
        constexpr int NITEMS = 4 * I_G + 2 * I_D + I_INQ + I_INKV + 2 * I_SQ + I_KV;
        for (int it = gw; it < NITEMS; it += NGW) {
            int r = it; const float* W; int ldw, col0 = 0, K = DM, N; const float* gain = nullptr; float scale = 1.f; bf16_t* WT; int rmode = 0, roff = 0;
            if (r < I_G) { W = args.in[3]; ldw = DFF; N = DFF; gain = args.in[2]; WT = Wgu1; rmode = 1; }
            else if ((r -= I_G) < I_G) { W = args.in[4]; ldw = DFF; N = DFF; gain = args.in[2]; WT = Wgu1; rmode = 2; }
            else if ((r -= I_G) < I_D) { W = args.in[5]; ldw = DM; N = DM; K = DFF; WT = Wd1; }
            else if ((r -= I_D) < I_INQ) { W = args.in[7]; ldw = INC; N = 512; gain = args.in[6]; scale = C2_SB; WT = Win; }
            else if ((r -= I_INQ) < I_INKV) { W = args.in[7]; ldw = INC; col0 = 512; N = 1024; gain = args.in[6]; WT = Win; roff = 512; }
            else if ((r -= I_INKV) < I_SQ) { W = args.in[10]; ldw = DM; N = DM; WT = Wout; }
            else if ((r -= I_SQ) < I_KV) { W = args.in[14]; ldw = 2 * DM; N = 2 * DM; WT = Wkv; }
            else if ((r -= I_KV) < I_SQ) { W = args.in[15]; ldw = DM; N = DM; WT = Wo; }
            else if ((r -= I_SQ) < I_G) { W = args.in[17]; ldw = DFF; N = DFF; gain = args.in[16]; WT = Wgu2; rmode = 1; }
            else if ((r -= I_G) < I_G) { W = args.in[18]; ldw = DFF; N = DFF; gain = args.in[16]; WT = Wgu2; rmode = 2; }
            else { r -= I_G; W = args.in[19]; ldw = DM; N = DM; K = DFF; WT = Wd2; }
            const int nblk = N / 32, kb = r / nblk, nb = r % nblk, k0 = 64 * kb, n0 = 32 * nb;
            const int drow0 = rmode == 0 ? roff + n0 : (n0 >> 7) * 256 + (rmode == 2 ? 128 : 0) + (n0 & 127);
            p0_transpose_item(W, ldw, col0 + n0, K, gain, scale, WT, drow0, k0, scr, lane);
        }
        if ((wave & 3) == 0) {
            const float* w_in = args.in[7]; const float* w_pool = args.in[8]; const float* pscale = args.in[9]; const float* gmix = args.in[6];
            for (int item = bx * 2 + (wave >> 2); item < 16 * 32; item += G * 2) {
                const int k = (item & 15) * 64 + lane, gd0 = item >> 4, g = gd0 >> 3, d0 = (gd0 & 7) * 16;
                const float* wr = w_in + (size_t)k * INC + 1536 + g * 128; const float* wp = w_pool + (size_t)g * 128 * 128 + d0;
                f32x4 a0 = {0.f, 0.f, 0.f, 0.f}, a1 = a0, a2 = a0, a3 = a0;
#pragma unroll 2
                for (int c = 0; c < 128; c += 4) { const f32x4 av = *(const f32x4*)(wr + c);
#pragma unroll
                    for (int e = 0; e < 4; ++e) { const f32x4* w4 = (const f32x4*)(wp + (size_t)(c + e) * 128); const float ae = av[e];
                        a0 += w4[0] * ae; a1 += w4[1] * ae; a2 += w4[2] * ae; a3 += w4[3] * ae; } }
                const float gk = gmix[k]; const f32x4* ps4 = (const f32x4*)(pscale + g * 128 + d0);
                a0 = a0 * ps4[0] * gk; a1 = a1 * ps4[1] * gk; a2 = a2 * ps4[2] * gk; a3 = a3 * ps4[3] * gk;
                bf16_t* o = Win + (size_t)(1536 + g * 128 + d0) * DM + k;
#pragma unroll
                for (int e = 0; e < 4; ++e) { o[(size_t)(e) * DM] = (bf16_t)(cvt_pk_bf16(a0[e], 0.f) & 0xffffu); o[(size_t)(4 + e) * DM] = (bf16_t)(cvt_pk_bf16(a1[e], 0.f) & 0xffffu);
                    o[(size_t)(8 + e) * DM] = (bf16_t)(cvt_pk_bf16(a2[e], 0.f) & 0xffffu); o[(size_t)(12 + e) * DM] = (bf16_t)(cvt_pk_bf16(a3[e], 0.f) & 0xffffu); }
            }
        }
        for (int m = gw; m < DM; m += NGW) {
            const f32x4* wr4 = (const f32x4*)(args.in[13] + (size_t)m * DM) + lane; const float gk = args.in[11][m] * C2_MEM; u32x2* o8 = (u32x2*)(Wq + (size_t)m * DM) + lane;
#pragma unroll
            for (int j = 0; j < 4; ++j) { const f32x4 v = wr4[64 * j] * gk; o8[64 * j] = (u32x2){cvt_pk_bf16(v[0], v[1]), cvt_pk_bf16(v[2], v[3])}; }
        }
        for (int m0 = gw * 4; m0 < T; m0 += NGW * 4) {
            f32x4 v[4][4]; float s[4];
#pragma unroll
            for (int r = 0; r < 4; ++r) { const f32x4* xr = (const f32x4*)(x + (size_t)(m0 + r) * DM) + lane;
#pragma unroll
                for (int j = 0; j < 4; ++j) v[r][j] = __builtin_nontemporal_load(xr + 64 * j); }
#pragma unroll
            for (int r = 0; r < 4; ++r) { s[r] = 0.f;
#pragma unroll
                for (int j = 0; j < 4; ++j) s[r] += dot4(v[r][j]);
                s[r] = wave_sum(s[r]);
                u32x2* o8 = (u32x2*)(Rb + (size_t)(m0 + r) * DM) + lane;
#pragma unroll
                for (int j = 0; j < 4; ++j) o8[64 * j] = (u32x2){cvt_pk_bf16(v[r][j][0], v[r][j][1]), cvt_pk_bf16(v[r][j][2], v[r][j][3])};
                if (lane < 4) ssq[(size_t)(m0 + r) * 4 + lane] = lane == 0 ? s[r] : 0.f; }
        }
        for (int m = gw; m < TM; m += NGW) {
            const f32x4* xr = (const f32x4*)(mem + (size_t)m * DM) + lane; const f32x4* gr = (const f32x4*)args.in[12] + lane; f32x4 v[4]; float s = 0.f;
#pragma unroll
            for (int j = 0; j < 4; ++j) { v[j] = xr[64 * j]; s += dot4(v[j]); }
            const float rs = __builtin_amdgcn_rsqf(wave_sum(s) * (1.f / DM) + EPS);
            u32x2* o8 = (u32x2*)(memn + (size_t)m * DM) + lane;
#pragma unroll
            for (int j = 0; j < 4; ++j) { const f32x4 gg = gr[64 * j]; const f32x4 y = v[j] * rs * gg; o8[64 * j] = (u32x2){cvt_pk_bf16(y[0], y[1]), cvt_pk_bf16(y[2], y[3])}; }
        }
        __syncthreads();
    }
    SEAM(0);
    if (IN(1)) REP(1) {
        pg8::Gemm g{Rb, Wgu1, DM, DM, DM, (long)256 * DM * 2, 0, (long)256 * DM * 2, 0, 30, 0}; pg8::StaticOrder S; S.init(T, 2 * DFF, G, bx, 1);
        pg8::EpiSwiGLU E{act, ssq};
        pg8::gemm_phase<pg8::EpiSwiGLU, 8>(ldsl, ldsl + SCR_OFF, g, S, E);
    }
    SEAM(1);
    if (IN(2)) REP(2) {
        pg8::Gemm g{act, Wd1, DFF, DFF, DFF, (long)256 * DFF * 2, 0, (long)256 * DFF * 2, 0, 30, 0}; pg8::StaticOrder S; S.init(T, DM, G, bx);
        pg8::EpiResid E{Rb, ssq, 0.5f};
        pg8::gemm_phase<pg8::EpiResid, 32>(ldsl, ldsl + SCR_OFF, g, S, E);
    }
    SEAM(2);
    if (IN(3)) REP(3) {
        {   pg8::Gemm g{Rb, Win, DM, DM, DM, (long)256 * DM * 2, 0, (long)256 * DM * 2, 0, 30, 0}; pg8::StaticOrder S; S.init(T, INC, G, bx, 1);
            pg8::EpiScale E{proj, INC, ssq, (long)256 * INC, 256, 30, 0};
            pg8::gemm_phase<pg8::EpiScale, 16>(ldsl, ldsl + SCR_OFF, g, S, E); }
        {
            pg8::Gemm g{memn, Wkv, DM, DM, DM, (long)256 * DM * 2, 0, (long)256 * DM * 2, 0, 30, 0}; pg8::StaticOrder S; S.init(TM, 2 * DM, G, bx);
            pg8::EpiScale E{KV, 2 * DM, nullptr, (long)256 * 2 * DM, 256, 30, 0};
            pg8::gemm_phase<pg8::EpiScale, 16>(ldsl, ldsl + SCR_OFF, g, S, E); }
    }
    SEAM(3);
    if (IN(4)) REP(4) {
        for (int u = bx; u < BATCH * 2 * 16; u += G) {
            const int i = u >> 8, xcd = u & 7, l = (u >> 3) & 31, qb2 = ((l & 15) + 5 * i) & 15, bh2 = (xcd + 8 * i) * 2 + (l >> 4);
            sb::sb_unit8(bh2 >> 1, bh2 & 1, qb2, proj, mix, (char*)lds, (volatile LAS unsigned*)(ldsl + SCR_OFF)); }
        for (int item = gw; item < (T / 64) * 4; item += NGW) {
            const int g = item & 3, t0 = (item >> 2) * 64 + (lane >> 4) * 16, c0 = g * 128 + (lane & 15) * 8;
            const bf16_t* y = proj + (size_t)t0 * INC + 1536 + c0; bf16_t* o = mix + (size_t)t0 * DM + 512 + c0; const int pos0 = t0 & (SEQ - 1);
            if (g == 0) pool_item<2>(y, o, pos0); else if (g == 1) pool_item<4>(y, o, pos0); else if (g == 2) pool_item<8>(y, o, pos0); else pool_item<16>(y, o, pos0);
        }
        __syncthreads();
        {
            pg8::Gemm g{KV, Wq, 2 * DM, DM, 256, (long)256 * 2 * DM * 2, 256 * 2, (long)256 * DM * 2, 0, 2, 256 * 2}; pg8::StaticOrder S; S.init(TM, 4 * DM, G, bx);
            pg8::EpiScale8K E{KqT, DM, nullptr, (long)DM * DM, 256, 2, (long)256 * DM};
            pg8::gemm_phase<pg8::EpiScale8K, 16>(ldsl, ldsl + SCR_OFF, g, S, E); }
        {
            pg8::Gemm g{Wo, KV + DM, DM, 2 * DM, 256, (long)256 * DM * 2, 256 * 2, (long)256 * 2 * DM * 2, 0, 5, 256 * 2}; pg8::StaticOrder S; S.init(DM, 4 * TM, G, bx);
            pg8::EpiScale8V E{VWoT, DM, nullptr, (long)256 * DM, (long)DM * DM, 5, 256};
            pg8::gemm_phase<pg8::EpiScale8V, 16>(ldsl, ldsl + SCR_OFF, g, S, E); }
    }
    SEAM(4);
    if (IN(5)) {
        pg8::Gemm g{mix, Wout, DM, DM, DM, (long)256 * DM * 2, 0, (long)256 * DM * 2, 0, 30, 0}; pg8::StaticOrder S; S.init(T, DM, G, bx, 1);
        pg8::EpiResid8 E{Rb, ssq, 1.0f};
        pg8::gemm_phase<pg8::EpiResid8, 32>(ldsl, ldsl + SCR_OFF, g, S, E);
    }
    SEAM(5);
    if (IN(6)) REP(6) {
        pg8::Gemm g{(const bf16_t*)X8, (const bf16_t*)KqT, DM / 2, DM / 2, DM / 2, (long)256 * DM, 0, 0, (long)DM * DM, 0, (long)256 * DM}; pg8::StaticOrder S; S.init(T, DM, G, bx);
        pg8::EpiSoftmax E{Ps8, ssq};
        pg8::gemm_phase<pg8::EpiSoftmax, 0, true>(ldsl, ldsl + SCR_OFF, g, S, E);
    }
    SEAM(6);
    if (IN(7)) {
        pg8::Gemm g{(const bf16_t*)Ps8, (const bf16_t*)VWoT, DM / 2, DM / 2, DM / 2, (long)256 * DM, 0, (long)256 * DM, (long)DM * DM, 30, 0}; pg8::StaticOrder S; S.init(T, DM, G, bx, 1);
        pg8::EpiResid E{Rb, ssq, 1.0f / (256.0f * F8_SV)};
        pg8::gemm_phase<pg8::EpiResid, 0, true>(ldsl, ldsl + SCR_OFF, g, S, E);
    }
    SEAM(7);
    if (IN(8)) REP(8) {
        pg8::Gemm g{Rb, Wgu2, DM, DM, DM, (long)256 * DM * 2, 0, (long)256 * DM * 2, 0, 30, 0}; pg8::StaticOrder S; S.init(T, 2 * DFF, G, bx);
        pg8::EpiSwiGLU E{act, ssq};
        pg8::gemm_phase<pg8::EpiSwiGLU, 8>(ldsl, ldsl + SCR_OFF, g, S, E);
    }
    SEAM(8);
    if (IN(9)) {
        pg8::Gemm g{act, Wd2, DFF, DFF, DFF, (long)256 * DFF * 2, 0, (long)256 * DFF * 2, 0, 30, 0}; pg8::StaticOrder S; S.init(T, DM, G, bx, 1);
        pg8::EpiResid E{Rb, ssq, 0.5f};
        pg8::gemm_phase<pg8::EpiResid, 32>(ldsl, ldsl + SCR_OFF, g, S, E);
    }
    SEAM(9);
    if (IN(10)) {
        const f32x4* gr = (const f32x4*)args.in[20]; f32x4 g0[2], g1[2];
#pragma unroll
        for (int j = 0; j < 2; ++j) { g0[j] = gr[(lane + 64 * j) * 2]; g1[j] = gr[(lane + 64 * j) * 2 + 1]; }
        for (int m0 = gw * 8; m0 < T; m0 += NGW * 8) {
            u32x4 v[8][2]; f32x4 sq[8];
#pragma unroll
            for (int r = 0; r < 8; ++r) { const u32x4* xr = (const u32x4*)(Rb + (size_t)(m0 + r) * DM) + lane; v[r][0] = xr[0]; v[r][1] = xr[64]; sq[r] = *(const f32x4*)(ssq + (size_t)(m0 + r) * 4); }
#pragma unroll
            for (int r = 0; r < 8; ++r) { const float rs = rstd4(sq[r]); f32x4* xw = (f32x4*)(out + (size_t)(m0 + r) * DM);
#pragma unroll
                for (int j = 0; j < 2; ++j) { const u32x4 b = v[r][j];
                    const f32x4 b0 = {bf_lo(b.x), bf_hi(b.x), bf_lo(b.y), bf_hi(b.y)}, b1 = {bf_lo(b.z), bf_hi(b.z), bf_lo(b.w), bf_hi(b.w)};
                    __builtin_nontemporal_store(b0 * rs * g0[j], xw + (lane + 64 * j) * 2); __builtin_nontemporal_store(b1 * rs * g1[j], xw + (lane + 64 * j) * 2 + 1); } }
        }
    }
    if (bx == 0 && tid == 0) __hip_atomic_store(readyw, 0u, __ATOMIC_RELAXED, __HIP_MEMORY_SCOPE_AGENT);
#undef IN
#undef SEAM
}

extern "C" void kernel_launch(void* const* d_in, const int* in_sizes, int n_in, void* d_out, int out_size, void* d_ws, size_t ws_size, hipStream_t stream) {
    static int grid = 0;
    if (grid == 0) {
        if (n_in != 21 || out_size != T * DM || ws_size < WS_END) { fprintf(stderr, "kernel_launch: unexpected problem (n_in %d out %d ws %zu)\n", n_in, out_size, ws_size); grid = -1; return; }
        int dev = 0, cus = 0, per_cu = 0;
        hipGetDevice(&dev); hipDeviceGetAttribute(&cus, hipDeviceAttributeMultiprocessorCount, dev);
        if (hipFuncSetAttribute((const void*)fwd_megakernel, hipFuncAttributeMaxDynamicSharedMemorySize, LDS_BYTES) != hipSuccess) { fprintf(stderr, "kernel_launch: hipFuncSetAttribute failed\n"); grid = -1; return; }
        if (hipOccupancyMaxActiveBlocksPerMultiprocessor(&per_cu, (const void*)fwd_megakernel, 512, LDS_BYTES) != hipSuccess || per_cu < 1) { fprintf(stderr, "kernel_launch: occupancy query says %d\n", per_cu); per_cu = 1; }
        (void)hipGetLastError();
        grid = cus * 1;
        (void)per_cu;
    }
    if (grid < 0) return;
    Args a{};
    for (int i = 0; i < 21; ++i) a.in[i] = (const float*)d_in[i];
    a.out = (float*)d_out; a.ws = (unsigned char*)d_ws;
#if MK_LAUNCHES_PER_PHASE
    for (int p = 0; p < NPHASE; ++p) { a.ph_lo = p; a.ph_hi = p + 1; hipLaunchKernelGGL(fwd_megakernel, dim3(grid), dim3(512), LDS_BYTES, stream, a); }
#else
    a.ph_lo = 0; a.ph_hi = NPHASE;
    void* kargs[] = {&a};
    hipError_t e = hipLaunchCooperativeKernel((const void*)fwd_megakernel, dim3(grid), dim3(512), kargs, LDS_BYTES, stream);
    if (e != hipSuccess) fprintf(stderr, "cooperative launch failed: %s (grid %d)\n", hipGetErrorString(e), grid);
#endif
}
```

```cpp
#include <hip/hip_runtime.h>
#include <hip/hip_cooperative_groups.h>
#include <cstdio>
#include <cstdint>
namespace cg = cooperative_groups;

#ifndef MK_LAUNCHES_PER_PHASE
#define MK_LAUNCHES_PER_PHASE 0
#endif

constexpr int BATCH = 32, SEQ = 2048, DM = 1024, T = BATCH * SEQ, DFF = 2816, MEM = 256, TM = BATCH * MEM;
constexpr int INC = 2048;
constexpr float LOG2E = 1.4426950408889634f;
constexpr float C2_SB = 0.125f * LOG2E;
constexpr float C2_MEM = 0.0625f * LOG2E;
constexpr float EPS = 1e-6f;
constexpr long X8_FROM_RB = (long)(234 + 128 + 64 - 106) * 1048576;

#define LAS __attribute__((address_space(3)))
typedef unsigned short bf16_t;
typedef short bf16x8 __attribute__((ext_vector_type(8)));
typedef short s16x4 __attribute__((ext_vector_type(4)));
typedef float f32x4 __attribute__((ext_vector_type(4)));
typedef float f32x16 __attribute__((ext_vector_type(16)));
typedef unsigned u32x4 __attribute__((ext_vector_type(4)));
typedef unsigned u32x2 __attribute__((ext_vector_type(2)));
typedef int v8i32 __attribute__((ext_vector_type(8)));

__device__ __forceinline__ unsigned cvt_pk_bf16(float lo, float hi) { unsigned r; asm volatile("v_cvt_pk_bf16_f32 %0, %1, %2" : "=v"(r) : "v"(lo), "v"(hi)); return r; }
__device__ __forceinline__ unsigned pk4_fp8(float a, float b, float c, float d) { int w = 0; w = __builtin_amdgcn_cvt_pk_fp8_f32(a, b, w, false); w = __builtin_amdgcn_cvt_pk_fp8_f32(c, d, w, true); return (unsigned)w; }
__device__ __forceinline__ float bf_lo(unsigned w) { return __uint_as_float(w << 16); }
__device__ __forceinline__ float bf_hi(unsigned w) { return __uint_as_float(w & 0xffff0000u); }
__device__ __forceinline__ float wave_sum(float v) {
#pragma unroll
    for (int o = 1; o < 64; o <<= 1) v += __shfl_xor(v, o);
    return v;
}
__device__ __forceinline__ float dot4(f32x4 v) { return (v[0] * v[0] + v[1] * v[1]) + (v[2] * v[2] + v[3] * v[3]); }
__device__ __forceinline__ float rstd4(f32x4 a) { return __builtin_amdgcn_rsqf(((a[0] + a[1]) + (a[2] + a[3])) * (1.f / DM) + EPS); }

namespace pg8 {
constexpr int BM = 256, BK = 64, HALF = 128, HTB = HALF * BK * 2, STAGE_BYTES = 8 * HTB, NXCD = 8, WGM = 8;
__host__ __device__ __forceinline__ int lds_byte(int r, int c) { const int st = (r >> 4) * 2 + (c >> 5), rr = r & 15, cc = c & 31, ob = rr * 64 + cc * 2; return st * 1024 + (ob ^ (((ob >> 9) & 1) << 5)); }
__host__ __device__ __forceinline__ void stage_rc(int b, int& R, int& C) { const int st = b / 1024, sb = b % 1024, swz = sb ^ (((sb >> 9) & 1) << 5); R = (st >> 1) * 16 + swz / 64; C = (st & 1) * 32 + (swz % 64) / 2; }
__host__ __device__ __forceinline__ int perm32(int rho) { const int n = rho >> 4, i = rho & 15; return 8 * (i >> 2) + 4 * n + (i & 3); }

struct Unit { int pm, pn; };
struct Gemm { const bf16_t* A; const bf16_t* Bt; int lda, ldb, K; long a_pm, a_pn, b_pn, b_pb; int pn_shift; long b_ph;
    __device__ __forceinline__ const char* abase(const Unit& u) const { return (const char*)A + (size_t)u.pm * a_pm + (size_t)(u.pn >> pn_shift) * a_pn; }
    __device__ __forceinline__ const char* bbase(const Unit& u) const { return (const char*)Bt + (size_t)(u.pn & ((1 << pn_shift) - 1)) * b_pn + (size_t)(u.pn >> pn_shift) * b_ph + (size_t)(u.pm >> 3) * b_pb; } };

struct StaticOrder {
    int nM, nN, nwg, G, c, rev;
    __device__ void init(int M, int N, int G_, int c_, int rev_ = 0) { nM = M / BM; nN = N / BM; nwg = nM * nN; G = G_; c = c_; rev = rev_; }
    __device__ bool next(int i, Unit& u) const {
        const long L = (long)i * G + c; if (L >= nwg) return false;
        int wgid = (int)L; { const int q = nwg / NXCD, r = nwg % NXCD, xcd = wgid % NXCD, off = wgid / NXCD; wgid = (xcd < r ? xcd * (q + 1) : r * (q + 1) + (xcd - r) * q) + off; }
        const int nig = WGM * nN, gid = wgid / nig, fm = gid * WGM, gsz = (nM - fm) < WGM ? (nM - fm) : WGM;
        u.pm = fm + ((wgid % nig) % gsz); u.pn = (wgid % nig) / gsz; if (rev) u.pm = nM - 1 - u.pm; return true;
    }
};

__device__ __forceinline__ void panel_rstd(const float* ssq, LAS unsigned char* scr, int pm, int wr, int fr, float (&rsv)[2][4]) {
    LAS float* rtab = (LAS float*)(scr + 4096); volatile LAS int* pf = (volatile LAS int*)(scr + 5120);
    if (*pf != pm) {
        asm volatile("s_waitcnt lgkmcnt(0)" ::: "memory"); __builtin_amdgcn_s_barrier(); asm volatile("" ::: "memory");
        const int t = threadIdx.x;
        if (t < BM) { rtab[t] = rstd4(*(const f32x4*)(ssq + (size_t)(pm * BM + t) * 4)); if (t == 0) *pf = pm; }
        asm volatile("s_waitcnt lgkmcnt(0)" ::: "memory"); __builtin_amdgcn_s_barrier(); asm volatile("" ::: "memory");
    }
#pragma unroll
    for (int ai = 0; ai < 2; ++ai)
#pragma unroll
        for (int m = 0; m < 4; ++m) rsv[ai][m] = rtab[ai * HALF + wr * 64 + m * 16 + fr];
}
typedef float f32x2 __attribute__((ext_vector_type(2)));
struct EpiSwiGLU {
    bf16_t* O; const float* ssq;
    __device__ __forceinline__ void operator()(const f32x4 (&acc)[2][2][4][2], const Unit& u, int wr, int wc, int fr, int fq, LAS unsigned char* scr) const {
        const int row0 = u.pm * BM + wr * 64 + fr, col0 = u.pn * HALF + wc * 32 + 8 * fq;
        float rsv[2][4]; panel_rstd(ssq, scr, u.pm, wr, fr, rsv);
#pragma unroll
        for (int ai = 0; ai < 2; ++ai)
#pragma unroll
            for (int m = 0; m < 4; ++m) {
                const int row = row0 + ai * HALF + m * 16; const float rs = rsv[ai][m], rs2 = rs * rs, ce = -rs * LOG2E; unsigned w[4];
#pragma unroll
                for (int n = 0; n < 2; ++n)
#pragma unroll
                    for (int j = 0; j < 4; j += 2) {
                        const f32x2 g = {acc[ai][0][m][n][j], acc[ai][0][m][n][j + 1]}, up = {acc[ai][1][m][n][j], acc[ai][1][m][n][j + 1]};
                        const f32x2 t = g * ce; f32x2 d; d.x = __builtin_amdgcn_exp2f(t.x); d.y = __builtin_amdgcn_exp2f(t.y); d = d + 1.0f;
                        f32x2 r; r.x = __builtin_amdgcn_rcpf(d.x); r.y = __builtin_amdgcn_rcpf(d.y);
                        const f32x2 o = (g * up) * (r * rs2); w[n * 2 + (j >> 1)] = cvt_pk_bf16(o.x, o.y); }
                *(u32x4*)(O + (size_t)row * DFF + col0) = (u32x4){w[0], w[1], w[2], w[3]}; }
    }
};
template <bool W8> struct EpiResidT {
    bf16_t* R; float* ssq; float alpha;
    __device__ __forceinline__ void operator()(const f32x4 (&acc)[2][2][4][2], const Unit& u, int wr, int wc, int fr, int fq, LAS unsigned char* scr) const {
        const int row0 = u.pm * BM + wr * 64 + fr, col0 = u.pn * BM + wc * 32 + 8 * fq;
        LAS float* tab = (LAS float*)scr;
        u32x4 bv[2][4][2];
#pragma unroll
        for (int ai = 0; ai < 2; ++ai)
#pragma unroll
            for (int m = 0; m < 4; ++m)
#pragma unroll
                for (int bj = 0; bj < 2; ++bj) bv[ai][m][bj] = *(const u32x4*)(R + (size_t)(row0 + ai * HALF + m * 16) * DM + col0 + bj * HALF);
#pragma unroll
        for (int ai = 0; ai < 2; ++ai)
#pragma unroll
            for (int m = 0; m < 4; ++m) {
                const int row = row0 + ai * HALF + m * 16; float s = 0.f;
#pragma unroll
                for (int bj = 0; bj < 2; ++bj) { const u32x4 b = bv[ai][m][bj];
                    const f32x4 b0 = {bf_lo(b.x), bf_hi(b.x), bf_lo(b.y), bf_hi(b.y)}, b1 = {bf_lo(b.z), bf_hi(b.z), bf_lo(b.w), bf_hi(b.w)};
                    const f32x4 v0 = b0 + acc[ai][bj][m][0] * alpha, v1 = b1 + acc[ai][bj][m][1] * alpha;
                    u32x4 w; w.x = cvt_pk_bf16(v0[0], v0[1]); w.y = cvt_pk_bf16(v0[2], v0[3]); w.z = cvt_pk_bf16(v1[0], v1[1]); w.w = cvt_pk_bf16(v1[2], v1[3]);
                    *(u32x4*)(R + (size_t)row * DM + col0 + bj * HALF) = w;
                    if constexpr (W8) *(u32x2*)((unsigned char*)R + X8_FROM_RB + (size_t)row * DM + col0 + bj * HALF) = (u32x2){pk4_fp8(v0[0], v0[1], v0[2], v0[3]), pk4_fp8(v1[0], v1[1], v1[2], v1[3])};
                    s += dot4(v0) + dot4(v1); }
                s += __shfl_xor(s, 16); s += __shfl_xor(s, 32); if (fq == 0) tab[(ai * HALF + wr * 64 + m * 16 + fr) * 4 + wc] = s;
            }
        asm volatile("s_waitcnt lgkmcnt(0)" ::: "memory"); __builtin_amdgcn_s_barrier(); asm volatile("" ::: "memory");
        const int t = threadIdx.x;
        if (t < BM) { const f32x4 v = *(const LAS f32x4*)(tab + t * 4); ssq[(size_t)(u.pm * BM + t) * 4 + u.pn] = (v[0] + v[1]) + (v[2] + v[3]); }
    }
};
template <bool W8, int F8S = 1> struct EpiScaleT {
    bf16_t* O; int ldc; const float* ssq; long pm_stride, pn_stride; int pn_shift; long ph_stride;
    __device__ __forceinline__ void operator()(const f32x4 (&acc)[2][2][4][2], const Unit& u, int wr, int wc, int fr, int fq, LAS unsigned char* scr) const {
        const int lr0 = wr * 64 + fr, lc0 = wc * 32 + 8 * fq;
        bf16_t* Ot = O + (size_t)u.pm * pm_stride + (size_t)(u.pn & ((1 << pn_shift) - 1)) * pn_stride + (size_t)(u.pn >> pn_shift) * ph_stride;
        float rsv[2][4];
        if (ssq) panel_rstd(ssq, scr, u.pm, wr, fr, rsv);
        else {
#pragma unroll
            for (int ai = 0; ai < 2; ++ai)
#pragma unroll
                for (int m = 0; m < 4; ++m) rsv[ai][m] = 1.0f; }
#pragma unroll
        for (int ai = 0; ai < 2; ++ai)
#pragma unroll
            for (int m = 0; m < 4; ++m) {
                const int lr = lr0 + ai * HALF + m * 16; const float rs = rsv[ai][m];
#pragma unroll
                for (int bj = 0; bj < 2; ++bj) { const f32x4 v0 = acc[ai][bj][m][0] * rs, v1 = acc[ai][bj][m][1] * rs;
                    if constexpr (W8) { const f32x4 y0 = v0 * (float)F8S, y1 = v1 * (float)F8S;
                        *(u32x2*)((unsigned char*)O + (size_t)u.pm * pm_stride + (size_t)(u.pn & ((1 << pn_shift) - 1)) * pn_stride + (size_t)(u.pn >> pn_shift) * ph_stride + (size_t)lr * ldc + lc0 + bj * HALF) =
                            (u32x2){pk4_fp8(y0[0], y0[1], y0[2], y0[3]), pk4_fp8(y1[0], y1[1], y1[2], y1[3])}; }
                    else { u32x4 w; w.x = cvt_pk_bf16(v0[0], v0[1]); w.y = cvt_pk_bf16(v0[2], v0[3]); w.z = cvt_pk_bf16(v1[0], v1[1]); w.w = cvt_pk_bf16(v1[2], v1[3]);
                        *(u32x4*)(Ot + (size_t)lr * ldc + lc0 + bj * HALF) = w; } } }
    }
};
typedef EpiResidT<false> EpiResid; typedef EpiResidT<true> EpiResid8; typedef EpiScaleT<false> EpiScale; typedef EpiScaleT<true, 64> EpiScale8K; typedef EpiScaleT<true, 4> EpiScale8V;
struct EpiSoftmax {
    unsigned char* P; const float* ssq;
    __device__ __forceinline__ void operator()(f32x4 (&acc)[2][2][4][2], const Unit& u, int wr, int wc, int fr, int fq, LAS unsigned char* scr) const {
        LAS float* tab = (LAS float*)scr;
        LAS float* tab2 = (LAS float*)(scr + 6144);
        float rsv[2][4]; panel_rstd(ssq, scr, u.pm, wr, fr, rsv);
#pragma unroll
        for (int ai = 0; ai < 2; ++ai)
#pragma unroll
            for (int m = 0; m < 4; ++m) {
                float mx = -3.0e38f; const float rs = rsv[ai][m] * (1.0f / 64.0f);
#pragma unroll
                for (int bj = 0; bj < 2; ++bj)
#pragma unroll
                    for (int n = 0; n < 2; ++n) { acc[ai][bj][m][n] = acc[ai][bj][m][n] * rs; const f32x4 x = acc[ai][bj][m][n]; mx = fmaxf(mx, fmaxf(fmaxf(x[0], x[1]), fmaxf(x[2], x[3]))); }
                mx = fmaxf(mx, __shfl_xor(mx, 16)); mx = fmaxf(mx, __shfl_xor(mx, 32));
                if (fq == 0) tab[(ai * HALF + wr * 64 + m * 16 + fr) * 4 + wc] = mx;
            }
        asm volatile("s_waitcnt lgkmcnt(0)" ::: "memory"); __builtin_amdgcn_s_barrier(); asm volatile("" ::: "memory");
#pragma unroll
        for (int ai = 0; ai < 2; ++ai)
#pragma unroll
            for (int m = 0; m < 4; ++m) {
                const int lr = ai * HALF + wr * 64 + m * 16 + fr;
                const f32x4 t = *(const LAS f32x4*)(tab + lr * 4); const float mx = fmaxf(fmaxf(t[0], t[1]), fmaxf(t[2], t[3])); float sm = 0.f;
#pragma unroll
                for (int bj = 0; bj < 2; ++bj)
#pragma unroll
                    for (int n = 0; n < 2; ++n) { f32x4 v;
#pragma unroll
                        for (int j = 0; j < 4; ++j) v[j] = __builtin_amdgcn_exp2f(acc[ai][bj][m][n][j] - mx);
                        acc[ai][bj][m][n] = v; sm += (v[0] + v[1]) + (v[2] + v[3]); }
                sm += __shfl_xor(sm, 16); sm += __shfl_xor(sm, 32); if (fq == 0) tab2[lr * 4 + wc] = sm;
            }
        asm volatile("s_waitcnt lgkmcnt(0)" ::: "memory"); __builtin_amdgcn_s_barrier(); asm volatile("" ::: "memory");
        const int row0 = u.pm * BM + wr * 64 + fr, col0 = u.pn * BM + wc * 32 + 8 * fq;
#pragma unroll
        for (int ai = 0; ai < 2; ++ai)
#pragma unroll
            for (int m = 0; m < 4; ++m) {
                const int lr = ai * HALF + wr * 64 + m * 16 + fr, row = row0 + ai * HALF + m * 16;
                const f32x4 t = *(const LAS f32x4*)(tab2 + lr * 4); const float inv = 256.0f / ((t[0] + t[1]) + (t[2] + t[3]));
#pragma unroll
                for (int bj = 0; bj < 2; ++bj) { const f32x4 v0 = acc[ai][bj][m][0] * inv, v1 = acc[ai][bj][m][1] * inv;
                    *(u32x2*)(P + (size_t)row * DM + col0 + bj * HALF) = (u32x2){pk4_fp8(v0[0], v0[1], v0[2], v0[3]), pk4_fp8(v1[0], v1[1], v1[2], v1[3])}; } }
    }
};

template <class Epi, int ESTORES = 0, bool F8 = false>
__device__ __forceinline__ void gemm_phase(LAS unsigned char* lds, LAS unsigned char* scr, const Gemm g, const StaticOrder& S, const Epi& E) {
    const int tid = threadIdx.x, wid = __builtin_amdgcn_readfirstlane(tid >> 6), lane = tid & 63, wr = wid >> 2, wc = wid & 3, fr = lane & 15, fq = lane >> 4;
    const int K = g.K, nt = K / BK;
    unsigned voffA, voffB;
    { int R, C; stage_rc(tid * 16, R, C); const int Rb = (R & ~31) + perm32(R & 31); voffA = (unsigned)(R * g.lda + C) * 2u; voffB = (unsigned)(Rb * g.ldb + C) * 2u; }
    const size_t dA = (size_t)64 * g.lda * 2, dB = (size_t)64 * g.ldb * 2;
    const size_t kstep = (size_t)(BK * 2);
    const size_t hstepA = (size_t)HALF * g.lda * 2, hstepB = (size_t)HALF * g.ldb * 2;
    const unsigned ldsw = (unsigned)wid * 1024u; const unsigned ldsbase = (unsigned)(size_t)lds;
    const int aoff = lds_byte(wr * 64 + fr, fq * 8), boff = lds_byte(wc * 32 + fr, fq * 8);
#define PG8_SA(b, h) (((b) * 2 + (h)) * HTB)
#define PG8_SB(b, h) ((4 + (b) * 2 + (h)) * HTB)
#define PG8_STAGE(bufoff, gbase, voff, dlt) do { _Pragma("unroll") for (int _i = 0; _i < 2; ++_i) { unsigned _keep; \
        asm volatile("s_mov_b32 %0, m0\n\ts_mov_b32 m0, %3\n\ts_nop 0\n\tglobal_load_lds_dwordx4 %1, %2\n\ts_mov_b32 m0, %0" \
            : "=&s"(_keep) : "v"(voff), "s"((const char*)(gbase) + _i * (dlt)), "s"((unsigned)(ldsbase + (bufoff) + ldsw + _i * 8192)) : "memory"); } } while (0)
#define PG8_LDA(dst, b, h) do { _Pragma("unroll") for (int m = 0; m < 4; ++m) _Pragma("unroll") for (int k = 0; k < 2; ++k) dst[m][k] = *(const LAS bf16x8*)(lds + PG8_SA(b, h) + aoff + m * 2048 + k * 1024); } while (0)
#define PG8_LDB(dst, b, h) do { _Pragma("unroll") for (int n = 0; n < 2; ++n) _Pragma("unroll") for (int k = 0; k < 2; ++k) dst[n][k] = *(const LAS bf16x8*)(lds + PG8_SB(b, h) + boff + n * 2048 + k * 1024); } while (0)
#define PG8_CAT(x) __builtin_bit_cast(v8i32, __builtin_shufflevector(x[0], x[1], 0, 1, 2, 3, 4, 5, 6, 7, 8, 9, 10, 11, 12, 13, 14, 15))
#define PG8_MMA(ai, bj, At, Bt) do { __builtin_amdgcn_s_setprio(1); _Pragma("unroll") for (int m = 0; m < 4; ++m) _Pragma("unroll") for (int n = 0; n < 2; ++n) { \
        if constexpr (F8) acc[ai][bj][m][n] = __builtin_amdgcn_mfma_scale_f32_16x16x128_f8f6f4(PG8_CAT(Bt[n]), PG8_CAT(At[m]), acc[ai][bj][m][n], 0, 0, 0, 0x7f7f7f7f, 0, 0x7f7f7f7f); \
        else { _Pragma("unroll") for (int k = 0; k < 2; ++k) acc[ai][bj][m][n] = __builtin_amdgcn_mfma_f32_16x16x32_bf16(Bt[n][k], At[m][k], acc[ai][bj][m][n], 0, 0, 0); } } \
        __builtin_amdgcn_s_setprio(0); } while (0)
#define PG8_WAIT_V(n) asm volatile("s_waitcnt vmcnt(" #n ")" ::: "memory")
#define PG8_WAIT_L(n) asm volatile("s_waitcnt lgkmcnt(" #n ")" ::: "memory")
#define PG8_BAR __builtin_amdgcn_s_barrier()
#define PG8_SCHED __builtin_amdgcn_sched_barrier(0)
    Unit cur, nxt; int ui = 0;
    if (!S.next(0, cur)) return;
    if (tid == 0) *(volatile LAS int*)(scr + 5120) = -1;
    f32x4 acc[2][2][4][2];
#pragma unroll
    for (int a = 0; a < 2; ++a)
#pragma unroll
        for (int b = 0; b < 2; ++b)
#pragma unroll
            for (int m = 0; m < 4; ++m)
#pragma unroll
                for (int n = 0; n < 2; ++n) acc[a][b][m][n] = (f32x4){0.f, 0.f, 0.f, 0.f};
    bf16x8 At[4][2], B0[2][2], B1[2][2];
    const char* cA = g.abase(cur);
    const char* cB = g.bbase(cur);
    PG8_STAGE(PG8_SB(0, 0), cB, voffB, dB); PG8_STAGE(PG8_SB(0, 1), cB + hstepB, voffB, dB); PG8_STAGE(PG8_SA(0, 0), cA, voffA, dA); PG8_STAGE(PG8_SA(0, 1), cA + hstepA, voffA, dA);
    if (wr == 1) PG8_BAR;
    PG8_WAIT_V(2); PG8_BAR;
    PG8_STAGE(PG8_SB(1, 0), cB + kstep, voffB, dB); PG8_STAGE(PG8_SA(1, 0), cA + kstep, voffA, dA); PG8_STAGE(PG8_SB(1, 1), cB + hstepB + kstep, voffB, dB);
    PG8_WAIT_V(6); PG8_BAR;
    for (;;) {
        const bool has_next = S.next(ui + 1, nxt);
        const char* nA = has_next ? g.abase(nxt) : cA;
        const char* nB = has_next ? g.bbase(nxt) : cB;
#define PG8_TRIP(W) do { \
            const bool last = (t == nt - 2); \
            const char* a1 = cA + (size_t)(t + 1) * kstep; \
            const char* a2 = last ? nA : cA + (size_t)(t + 2) * kstep; const char* b2 = last ? nB : cB + (size_t)(t + 2) * kstep; \
            const char* a3 = a2 + kstep; const char* b3 = b2 + kstep; \
            PG8_LDB(B0, 0, 0); PG8_LDB(B1, 0, 1); PG8_SCHED; PG8_LDA(At, 0, 0); PG8_STAGE(PG8_SA(1, 1), a1 + hstepA, voffA, dA); \
            PG8_WAIT_V(W); PG8_WAIT_L(0); PG8_BAR; PG8_MMA(0, 0, At, B0); PG8_MMA(0, 1, At, B1); PG8_BAR; PG8_SCHED; \
            PG8_LDA(At, 0, 1); PG8_STAGE(PG8_SB(0, 0), b2, voffB, dB); PG8_STAGE(PG8_SB(0, 1), b2 + hstepB, voffB, dB); PG8_STAGE(PG8_SA(0, 0), a2, voffA, dA); \
            PG8_WAIT_V(W); PG8_WAIT_L(0); PG8_BAR; PG8_MMA(1, 0, At, B0); PG8_MMA(1, 1, At, B1); PG8_BAR; PG8_SCHED; \
            PG8_LDB(B0, 1, 0); PG8_LDB(B1, 1, 1); PG8_SCHED; PG8_LDA(At, 1, 0); PG8_STAGE(PG8_SA(0, 1), a2 + hstepA, voffA, dA); \
            PG8_WAIT_V(8); PG8_WAIT_L(0); PG8_BAR; PG8_MMA(0, 0, At, B0); PG8_MMA(0, 1, At, B1); PG8_BAR; PG8_SCHED; \
            PG8_LDA(At, 1, 1); PG8_STAGE(PG8_SB(1, 0), b3, voffB, dB); PG8_STAGE(PG8_SB(1, 1), b3 + hstepB, voffB, dB); PG8_STAGE(PG8_SA(1, 0), a3, voffA, dA); \
            PG8_WAIT_V(8); PG8_WAIT_L(0); PG8_BAR; PG8_MMA(1, 0, At, B0); PG8_MMA(1, 1, At, B1); PG8_BAR; PG8_SCHED; } while (0)
        int t = 0;
        if (ESTORES > 0 && ui > 0) { if constexpr (ESTORES == 8) PG8_TRIP(16); else if constexpr (ESTORES == 16) PG8_TRIP(24); else if constexpr (ESTORES == 32) PG8_TRIP(40); t = 2; }
        for (; t < nt; t += 2) PG8_TRIP(8);
#undef PG8_TRIP
        if (wr == 0) PG8_BAR;
        { int fr_o = fr, fq_o = fq; asm volatile("" : "+v"(fr_o), "+v"(fq_o));
          E(acc, cur, wr, wc, fr_o, fq_o, scr); }
        if (!has_next) break;
#pragma unroll
        for (int a = 0; a < 2; ++a)
#pragma unroll
            for (int b = 0; b < 2; ++b)
#pragma unroll
                for (int m = 0; m < 4; ++m)
#pragma unroll
                    for (int n = 0; n < 2; ++n) acc[a][b][m][n] = (f32x4){0.f, 0.f, 0.f, 0.f};
        cur = nxt; cA = nA; cB = nB; ++ui;
        if (wr == 1) PG8_BAR;
    }
    PG8_WAIT_V(0);
    PG8_BAR;
#undef PG8_SA
#undef PG8_SB
#undef PG8_STAGE
#undef PG8_LDA
#undef PG8_LDB
#undef PG8_MMA
#undef PG8_CAT
#undef PG8_WAIT_V
#undef PG8_WAIT_L
#undef PG8_BAR
#undef PG8_SCHED
}
}

namespace sb {
constexpr int PITCH = INC;
constexpr int SLOTB = 8192, LDS_K = 0, LDS_V = 2 * SLOTB, LDS_FLAG = 4 * SLOTB, LDS_OST = LDS_FLAG + 256, LDS_BYTES = LDS_OST + 8 * 4096;
constexpr float DONE_THR = -150.0f;
typedef LAS const char* lds_cptr;
typedef short v4i16_t __attribute__((ext_vector_type(4)));
__device__ __forceinline__ int crow(int r, int hi) { return (r & 3) + 8 * (r >> 2) + 4 * hi; }
__device__ __forceinline__ void glds16(const void* gsrc, unsigned lds_dst) { unsigned keep;
    asm volatile("s_mov_b32 %0, m0\n\ts_mov_b32 m0, %2\n\ts_nop 0\n\tglobal_load_lds_dwordx4 %1, off\n\ts_mov_b32 m0, %0" : "=&s"(keep) : "v"(gsrc), "s"(lds_dst) : "memory"); }
__device__ __forceinline__ s16x4 vtr(lds_cptr p) { return __builtin_bit_cast(s16x4, __builtin_amdgcn_ds_read_tr16_b64_v4i16((LAS v4i16_t*)p)); }
__device__ __forceinline__ float xhalf(float v, int hi) {
    auto rr = __builtin_amdgcn_permlane32_swap(__float_as_uint(v), __float_as_uint(v), false, false);
    return __uint_as_float(hi ? rr[0] : rr[1]);
}
#define SB_WAIT_BAR(N) asm volatile("s_waitcnt vmcnt(" #N ") lgkmcnt(0)\n\ts_barrier" ::: "memory")

__device__ __forceinline__ void sb_tile(lds_cptr kp, lds_cptr vp, const bf16x8 (&qr)[4], f32x16 (&o)[2], float& carry, bool& wdone, bool diag, int kb, int tq, int hi, int ksw) {
    f32x16 p0 = f32x16{}, p1 = f32x16{};
#pragma unroll
    for (int d0 = 0; d0 < 4; ++d0) {
        const int ko = ((2 * d0 + hi) ^ ksw) * 16;
        const bf16x8 b0 = *(const LAS bf16x8*)(kp + ko), b1 = *(const LAS bf16x8*)(kp + ko + 4096);
        p0 = __builtin_amdgcn_mfma_f32_32x32x16_bf16(b0, qr[d0], p0, 0, 0, 0);
        p1 = __builtin_amdgcn_mfma_f32_32x32x16_bf16(b1, qr[d0], p1, 0, 0, 0); }
    f32x16 l0, l1;
#pragma unroll
    for (int r = 0; r < 16; ++r) {
        { const float z = fminf(p0[r], 126.f); const float L2 = __builtin_amdgcn_logf(1.0f + __builtin_amdgcn_exp2f(z)); l0[r] = -L2; p0[r] = z - L2; }
        { const float z = fminf(p1[r], 126.f); const float L2 = __builtin_amdgcn_logf(1.0f + __builtin_amdgcn_exp2f(z)); l1[r] = -L2; p1[r] = z - L2; }
    }
    if (diag) {
#pragma unroll
        for (int r = 0; r < 16; ++r) { const int kv = kb + (r & 3) + 8 * (r >> 2);
            if (kv >= tq) { l0[r] = 0.f; p0[r] = -1.0e30f; }
            if (kv + 32 >= tq) { l1[r] = 0.f; p1[r] = -1.0e30f; } }
    }
    float gs[8], ps[8];
#pragma unroll
    for (int g = 0; g < 4; ++g) { gs[g] = (l0[4 * g] + l0[4 * g + 1]) + (l0[4 * g + 2] + l0[4 * g + 3]); gs[4 + g] = (l1[4 * g] + l1[4 * g + 1]) + (l1[4 * g + 2] + l1[4 * g + 3]); }
#pragma unroll
    for (int g = 0; g < 8; ++g) ps[g] = xhalf(gs[g], hi);
    float run = carry;
#pragma unroll
    for (int g = 7; g >= 0; --g) {
        const float base = run + (hi ? 0.f : ps[g]);
        if (g >= 4) { const int q = 4 * (g - 4);
            const float e3 = base, e2 = e3 + l1[q + 3], e1 = e2 + l1[q + 2], e0 = e1 + l1[q + 1];
            p1[q + 3] = __builtin_amdgcn_exp2f(p1[q + 3] + e3); p1[q + 2] = __builtin_amdgcn_exp2f(p1[q + 2] + e2);
            p1[q + 1] = __builtin_amdgcn_exp2f(p1[q + 1] + e1); p1[q] = __builtin_amdgcn_exp2f(p1[q] + e0);
        } else { const int q = 4 * g;
            const float e3 = base, e2 = e3 + l0[q + 3], e1 = e2 + l0[q + 2], e0 = e1 + l0[q + 1];
            p0[q + 3] = __builtin_amdgcn_exp2f(p0[q + 3] + e3); p0[q + 2] = __builtin_amdgcn_exp2f(p0[q + 2] + e2);
            p0[q + 1] = __builtin_amdgcn_exp2f(p0[q + 1] + e1); p0[q] = __builtin_amdgcn_exp2f(p0[q] + e0);
        }
        run += gs[g] + ps[g];
    }
    carry = run;
    wdone = __all(carry < DONE_THR);
    u32x4 pw0, pw1, pw2, pw3;
    pw0 = (u32x4){cvt_pk_bf16(p0[0], p0[1]), cvt_pk_bf16(p0[2], p0[3]), cvt_pk_bf16(p0[4], p0[5]), cvt_pk_bf16(p0[6], p0[7])};
    pw1 = (u32x4){cvt_pk_bf16(p0[8], p0[9]), cvt_pk_bf16(p0[10], p0[11]), cvt_pk_bf16(p0[12], p0[13]), cvt_pk_bf16(p0[14], p0[15])};
    pw2 = (u32x4){cvt_pk_bf16(p1[0], p1[1]), cvt_pk_bf16(p1[2], p1[3]), cvt_pk_bf16(p1[4], p1[5]), cvt_pk_bf16(p1[6], p1[7])};
    pw3 = (u32x4){cvt_pk_bf16(p1[8], p1[9]), cvt_pk_bf16(p1[10], p1[11]), cvt_pk_bf16(p1[12], p1[13]), cvt_pk_bf16(p1[14], p1[15])};
#define SB_VFR(lo, hi_) (bf16x8){lo[0], lo[1], lo[2], lo[3], hi_[0], hi_[1], hi_[2], hi_[3]}
#pragma unroll
    for (int d0 = 0; d0 < 2; ++d0) {
        s16x4 vlo[4], vhi[4];
#pragma unroll
        for (int ks = 0; ks < 4; ++ks) { vlo[ks] = vtr(vp + d0 * 4096 + ks * 1024); vhi[ks] = vtr(vp + d0 * 4096 + ks * 1024 + 512); }
        o[d0] = __builtin_amdgcn_mfma_f32_32x32x16_bf16(__builtin_bit_cast(bf16x8, pw0), SB_VFR(vlo[0], vhi[0]), o[d0], 0, 0, 0);
        o[d0] = __builtin_amdgcn_mfma_f32_32x32x16_bf16(__builtin_bit_cast(bf16x8, pw1), SB_VFR(vlo[1], vhi[1]), o[d0], 0, 0, 0);
        o[d0] = __builtin_amdgcn_mfma_f32_32x32x16_bf16(__builtin_bit_cast(bf16x8, pw2), SB_VFR(vlo[2], vhi[2]), o[d0], 0, 0, 0);
        o[d0] = __builtin_amdgcn_mfma_f32_32x32x16_bf16(__builtin_bit_cast(bf16x8, pw3), SB_VFR(vlo[3], vhi[3]), o[d0], 0, 0, 0);
    }
#undef SB_VFR
}

constexpr int STG = 65536, V_OFF = 32768;
__device__ __forceinline__ void sb_unit8(int b, int hg, int qb2, const bf16_t* proj, bf16_t* mix, char* shm, volatile LAS unsigned* flag) {
    const int tid = threadIdx.x, lane = tid & 63, r32 = lane & 31, hi = lane >> 5; const int wid = __builtin_amdgcn_readfirstlane(tid >> 6);
    const int hh = wid >> 1, h = hg * 4 + hh, sub = wid & 1;
    const long rowbase = (long)b * SEQ; const int q0 = qb2 * 128;
    const unsigned lds0 = (unsigned)(uintptr_t)shm;
    const int krow = 8 * wid + (lane >> 3);
    const bf16_t* ksrc = proj + rowbase * PITCH + 512 + hg * 256 + (long)krow * PITCH + (((lane & 7) ^ ((krow >> 1) & 7)) * 8);
    const bf16_t* vsrc = proj + rowbase * PITCH + 1024 + hg * 256 + (long)(16 * (wid & 3) + (lane >> 2)) * PITCH + (wid >> 2) * 32 + (lane & 3) * 8;
    const unsigned kdst = lds0 + wid * 1024, vdst = lds0 + V_OFF + wid * 1024;
#define DMA_KV(t, stg) do { _Pragma("unroll") for (int x_ = 0; x_ < 4; ++x_) { \
        glds16(ksrc + x_ * 64 + (long)(t) * 64 * PITCH, (unsigned)__builtin_amdgcn_readfirstlane(kdst + (stg) + x_ * 8192)); \
        glds16(vsrc + x_ * 64 + (long)(t) * 64 * PITCH, (unsigned)__builtin_amdgcn_readfirstlane(vdst + (stg) + x_ * 8192)); } } while (0)
    const lds_cptr shm3 = (lds_cptr)shm;
    const lds_cptr kp0 = shm3 + hh * 8192 + r32 * 128; const int ksw = (r32 >> 1) & 7;
    const lds_cptr vp0 = shm3 + V_OFF + hh * 8192 + ((lane >> 4) & 1) * 32 + (lane & 3) * 8 + (4 * hi + ((lane & 15) >> 2)) * 64;
    const int jtop = 2 * qb2 + 1;
    DMA_KV(jtop, 0);
    bf16x8 qa[4], qb[4];
    {   const bf16_t* Qa = proj + (rowbase + q0 + 64 + sub * 32) * PITCH + h * 64; const bf16_t* Qb = proj + (rowbase + q0 + sub * 32) * PITCH + h * 64;
#pragma unroll
        for (int d0 = 0; d0 < 4; ++d0) { qa[d0] = *reinterpret_cast<const bf16x8*>(&Qa[(long)r32 * PITCH + d0 * 16 + hi * 8]); qb[d0] = *reinterpret_cast<const bf16x8*>(&Qb[(long)r32 * PITCH + d0 * 16 + hi * 8]); } }
    asm volatile("" : "+v"(qa[0]), "+v"(qa[1]), "+v"(qa[2]), "+v"(qa[3]), "+v"(qb[0]), "+v"(qb[1]), "+v"(qb[2]), "+v"(qb[3]));
    f32x16 oa[2], ob[2]; oa[0] = f32x16{}; oa[1] = f32x16{}; ob[0] = f32x16{}; ob[1] = f32x16{};
    float ca = 0.f, cb = 0.f; bool da = false, db = false;
    const int tqa = q0 + 64 + sub * 32 + r32, tqb = q0 + sub * 32 + r32;
    int stage = 0;
    for (int it = 0, j = jtop;; ++it, --j) {
        stage = (it & 1) * STG; const int nstage = STG - stage;
        if (j > 0) { DMA_KV(j - 1, nstage); SB_WAIT_BAR(8); } else { SB_WAIT_BAR(0); }
        const int kb = 64 * j + 4 * hi;
        if (!da) sb_tile(kp0 + stage, vp0 + stage, qa, oa, ca, da, j == jtop, kb, tqa, hi, ksw);
        if (!db && j < jtop) sb_tile(kp0 + stage, vp0 + stage, qb, ob, cb, db, j == jtop - 1, kb, tqb, hi, ksw);
        if (lane == 0) flag[wid] = (da && db) ? 1u : 0u;
        asm volatile("s_waitcnt lgkmcnt(0)\n\ts_barrier" ::: "memory");
        unsigned alld = 1u;
#pragma unroll
        for (int w = 0; w < 8; ++w) alld &= flag[w];
        if (alld || j == 0) break;
    }
    {   bf16_t* stg = (bf16_t*)(shm + stage) + wid * 4096;
#pragma unroll
        for (int r = 0; r < 16; ++r) { const int orow = crow(r, hi);
#pragma unroll
            for (int d0 = 0; d0 < 2; ++d0) { stg[orow * 64 + d0 * 32 + r32] = (bf16_t)(cvt_pk_bf16(oa[d0][r], 0.f) & 0xffffu); stg[2048 + orow * 64 + d0 * 32 + r32] = (bf16_t)(cvt_pk_bf16(ob[d0][r], 0.f) & 0xffffu); } }
        asm volatile("s_waitcnt lgkmcnt(0)" ::: "memory");
        bf16_t* Oa = mix + (rowbase + q0 + 64 + sub * 32) * DM + h * 64; bf16_t* Ob = mix + (rowbase + q0 + sub * 32) * DM + h * 64;
#pragma unroll
        for (int i = 0; i < 4; ++i) { const int row = i * 8 + (lane >> 3), ch = lane & 7;
            const u32x4 va = *(const u32x4*)(stg + row * 64 + ch * 8), vb = *(const u32x4*)(stg + 2048 + row * 64 + ch * 8);
            *(u32x4*)(Oa + (long)row * DM + ch * 8) = va; *(u32x4*)(Ob + (long)row * DM + ch * 8) = vb; } }
    asm volatile("s_waitcnt vmcnt(0) lgkmcnt(0)\n\ts_barrier" ::: "memory");
#undef DMA_KV
}
#undef SB_WAIT_BAR
}

#define XB_TMO      128
#define XB_XCNT(j)  (256  + 64 * (j))
#define XB_XSUB(j)  (1280 + 64 * (j))
#define XB_XGEN(j)  (2304 + 64 * (j))
#define XB_TOP      3328
#define XB_TOPGEN   3392
#define XCD_BAR_WORDS 3456
#define XB_SPIN_CAP (1u << 18)
__device__ __forceinline__ unsigned xb_ld(unsigned* p)              { return __hip_atomic_load(p, __ATOMIC_RELAXED, __HIP_MEMORY_SCOPE_AGENT); }
__device__ __forceinline__ unsigned xb_add(unsigned* p, unsigned v) { return __hip_atomic_fetch_add(p, v, __ATOMIC_RELAXED, __HIP_MEMORY_SCOPE_AGENT); }
__device__ __forceinline__ unsigned xb_xcc_id() { return (unsigned)__builtin_amdgcn_s_getreg((3 << 11) | 20) & 0xFu; }
#define XB_SPIN(cond, bar) do { unsigned _sp = 0; while (cond) { __builtin_amdgcn_s_sleep(1); \
    if ((++_sp & 255u) == 0u) { if (xb_ld(&(bar)[XB_TMO])) break; if (_sp > XB_SPIN_CAP) { atomicAdd(&(bar)[XB_TMO], 1u); break; } } } } while (0)
struct XcdBarrier { unsigned* bar; unsigned x; volatile LAS unsigned* st; };
__device__ __forceinline__ XcdBarrier xcd_barrier_post(unsigned* bar, volatile LAS unsigned* st) {
    XcdBarrier b; b.bar = bar; b.x = xb_xcc_id(); b.st = st;
    if (threadIdx.x == 0) (void)xb_add(&bar[XB_XCNT(b.x)], 1u);
    return b;
}
__device__ __forceinline__ void xcd_barrier_complete(unsigned* bar, unsigned x, unsigned& nloc, unsigned& nx) {
    const unsigned G = gridDim.x * gridDim.y * gridDim.z;
    unsigned sum, cnt, mine, sp = 0u;
    for (;;) {
        sum = 0u; cnt = 0u; mine = 0u;
#pragma unroll
        for (unsigned j = 0; j < 16; ++j) { const unsigned c = xb_ld(&bar[XB_XCNT(j)]); sum += c; cnt += (c > 0u) ? 1u : 0u; mine = (j == x) ? c : mine; }
        if (sum == G) break;
        __builtin_amdgcn_s_sleep(1);
        if ((++sp & 255u) == 0u) { if (xb_ld(&bar[XB_TMO])) break; if (sp > XB_SPIN_CAP) { atomicAdd(&bar[XB_TMO], 1u); break; } }
    }
    nloc = mine > 0u ? mine : 1u; nx = cnt > 0u ? cnt : 1u;
}
__device__ __forceinline__ void xcd_barrier(const XcdBarrier& b) {
    asm volatile("s_waitcnt vmcnt(0)" ::: "memory");
    __syncthreads();
    if (threadIdx.x == 0) {
        unsigned* bar = b.bar;
        __builtin_amdgcn_s_waitcnt(0);
        unsigned nloc = b.st[0], nx = b.st[1];
        if (nloc == 0u) { xcd_barrier_complete(bar, b.x, nloc, nx); b.st[0] = nloc; b.st[1] = nx; }
        const unsigned old = xb_add(&bar[XB_XSUB(b.x)], 1u);
        const unsigned gen = old / nloc;
        if (old + 1u == (gen + 1u) * nloc) {
            __builtin_amdgcn_fence(__ATOMIC_RELEASE, "agent");
            asm volatile("s_waitcnt vmcnt(0)" ::: "memory");
            const unsigned og = xb_add(&bar[XB_TOP], 1u);
            const unsigned tg = og / nx;
            if (og + 1u == (tg + 1u) * nx) xb_add(&bar[XB_TOPGEN], 1u);
            else XB_SPIN(xb_ld(&bar[XB_TOPGEN]) == tg, bar);
            __builtin_amdgcn_fence(__ATOMIC_ACQUIRE, "agent");
            xb_add(&bar[XB_XGEN(b.x)], 1u);
            asm volatile("s_waitcnt vmcnt(0)" ::: "memory");
        } else {
            XB_SPIN(xb_ld(&bar[XB_XGEN(b.x)]) == gen, bar);
            __builtin_amdgcn_fence(__ATOMIC_ACQUIRE, "agent");
            asm volatile("s_waitcnt vmcnt(0)" ::: "memory");
        }
    }
    __syncthreads();
}

constexpr size_t MiB = 1u << 20;
constexpr size_t WS_WGU1 = 1 * MiB, WS_WD1 = 12 * MiB, WS_WIN = 18 * MiB, WS_WOUT = 22 * MiB, WS_WQ = 24 * MiB, WS_WKV = 26 * MiB, WS_WO = 30 * MiB,
                 WS_WGU2 = 32 * MiB, WS_WD2 = 43 * MiB;
constexpr size_t WS_SSQ = 50 * MiB, WS_LSUM = 54 * MiB;
constexpr size_t WS_MEMN = 58 * MiB, WS_KM = 74 * MiB, WS_VT = 90 * MiB;
constexpr size_t WS_RB = 106 * MiB;
constexpr size_t WS_BIG = 234 * MiB;
constexpr size_t WS_PROJ = WS_BIG, WS_MIX = WS_BIG + 256 * MiB, WS_QM = WS_BIG, WS_PS = WS_BIG + 128 * MiB, WS_OM = WS_MIX;
constexpr size_t WS_KQT = WS_BIG + 384 * MiB, WS_VWOT = WS_KQT + 64 * MiB;
constexpr size_t WS_END = WS_VWOT + 64 * MiB;
static_assert(WS_WGU1 + (size_t)2 * DFF * DM * 2 <= WS_WD1 && WS_WD1 + (size_t)DM * DFF * 2 <= WS_WIN && WS_WGU2 + (size_t)2 * DFF * DM * 2 <= WS_WD2 && WS_WD2 + (size_t)DM * DFF * 2 <= WS_SSQ, "ws map");
static_assert((size_t)T * DFF * 2 <= 384 * MiB, "act fits");
static_assert((long)(WS_PS + 64 * MiB) - (long)WS_RB == X8_FROM_RB, "X8_FROM_RB");

constexpr int RING_BYTES = 131072, SCR_OFF = RING_BYTES, XBST_OFF = 143360, LDS_BYTES = 147456;
constexpr int NPHASE = 11;
constexpr float F8_SK = 64.0f, F8_SV = 4.0f;

struct Args { const float* in[21]; float* out; unsigned char* ws; int ph_lo, ph_hi; };

template <int W> __device__ __forceinline__ void pool_item(const bf16_t* __restrict__ y, bf16_t* __restrict__ o, int pos0) {
    u32x4 R[W - 1 + 16];
#pragma unroll
    for (int i = 0; i < W - 1; ++i) { const int d = W - 1 - i; R[i] = (pos0 - d >= 0) ? *(const u32x4*)(y - (ptrdiff_t)d * INC) : (u32x4){0u, 0u, 0u, 0u}; }
#pragma unroll
    for (int tt = 0; tt < 16; ++tt) R[W - 1 + tt] = *(const u32x4*)(y + (size_t)tt * INC);
    float sum[8];
#pragma unroll
    for (int e = 0; e < 8; ++e) sum[e] = 0.f;
#pragma unroll
    for (int i = 0; i < W - 1; ++i) { const u32x4 v = R[i];
        sum[0] += bf_lo(v.x); sum[1] += bf_hi(v.x); sum[2] += bf_lo(v.y); sum[3] += bf_hi(v.y); sum[4] += bf_lo(v.z); sum[5] += bf_hi(v.z); sum[6] += bf_lo(v.w); sum[7] += bf_hi(v.w); }
#pragma unroll
    for (int tt = 0; tt < 16; ++tt) { const u32x4 v = R[W - 1 + tt];
        const float cur[8] = {bf_lo(v.x), bf_hi(v.x), bf_lo(v.y), bf_hi(v.y), bf_lo(v.z), bf_hi(v.z), bf_lo(v.w), bf_hi(v.w)};
        const int pos = pos0 + tt; const float inv = 1.0f / (float)(pos + 1 < W ? pos + 1 : W); float r[8];
#pragma unroll
        for (int e = 0; e < 8; ++e) { sum[e] += cur[e]; r[e] = sum[e] * inv - cur[e]; }
        u32x4 wv; wv.x = cvt_pk_bf16(r[0], r[1]); wv.y = cvt_pk_bf16(r[2], r[3]); wv.z = cvt_pk_bf16(r[4], r[5]); wv.w = cvt_pk_bf16(r[6], r[7]);
        *(u32x4*)(o + (size_t)tt * DM) = wv;
        const u32x4 q = R[tt];
        sum[0] -= bf_lo(q.x); sum[1] -= bf_hi(q.x); sum[2] -= bf_lo(q.y); sum[3] -= bf_hi(q.y); sum[4] -= bf_lo(q.z); sum[5] -= bf_hi(q.z); sum[6] -= bf_lo(q.w); sum[7] -= bf_hi(q.w); }
}

__device__ __forceinline__ void p0_transpose_item(const float* W, int ldw, int colsrc, int K, const float* gain, float scale, bf16_t* WT, int drow0, int k0, LAS float* scr, int lane) {
    float wv[32];
#pragma unroll
    for (int i = 0; i < 32; ++i) { const int kk = 2 * i + (lane >> 5); wv[i] = __builtin_nontemporal_load(W + (size_t)(k0 + kk) * ldw + colsrc + (lane & 31)); }
#pragma unroll
    for (int i = 0; i < 32; ++i) { const int kk = 2 * i + (lane >> 5); const float gk = gain ? gain[k0 + kk] * scale : scale;
        scr[kk * 33 + (lane & 31)] = wv[i] * gk; }
    asm volatile("s_waitcnt lgkmcnt(0)" ::: "memory");
    const int c = lane & 7;
#pragma unroll
    for (int j = 0; j < 4; ++j) { const int n = (lane >> 3) + 8 * j; const LAS float* s = scr + (8 * c) * 33 + n;
        u32x4 o; o.x = cvt_pk_bf16(s[0 * 33], s[1 * 33]); o.y = cvt_pk_bf16(s[2 * 33], s[3 * 33]); o.z = cvt_pk_bf16(s[4 * 33], s[5 * 33]); o.w = cvt_pk_bf16(s[6 * 33], s[7 * 33]);
        *(u32x4*)(WT + (size_t)(drow0 + n) * K + k0 + 8 * c) = o; }
    asm volatile("s_waitcnt lgkmcnt(0)" ::: "memory");
}

__global__ void __launch_bounds__(512, 2) fwd_megakernel(Args args) {
    extern __shared__ __attribute__((aligned(16))) unsigned char lds[];
    LAS unsigned char* ldsl = (LAS unsigned char*)lds;
    const int tid = threadIdx.x, lane = tid & 63, wave = __builtin_amdgcn_readfirstlane(tid >> 6);
    const int G = gridDim.x, bx = blockIdx.x;
    const int gw = bx * 8 + wave, NGW = G * 8;
    unsigned char* ws = args.ws;
    const float* x = args.in[0]; const float* mem = args.in[1];
    float* out = args.out;
    bf16_t* Wgu1 = (bf16_t*)(ws + WS_WGU1); bf16_t* Wd1 = (bf16_t*)(ws + WS_WD1); bf16_t* Win = (bf16_t*)(ws + WS_WIN); bf16_t* Wout = (bf16_t*)(ws + WS_WOUT);
    bf16_t* Wq = (bf16_t*)(ws + WS_WQ); bf16_t* Wkv = (bf16_t*)(ws + WS_WKV); bf16_t* Wo = (bf16_t*)(ws + WS_WO); bf16_t* Wgu2 = (bf16_t*)(ws + WS_WGU2); bf16_t* Wd2 = (bf16_t*)(ws + WS_WD2);
    float* ssq = (float*)(ws + WS_SSQ);
    bf16_t* memn = (bf16_t*)(ws + WS_MEMN); bf16_t* KV = (bf16_t*)(ws + WS_KM);
    bf16_t* KqT = (bf16_t*)(ws + WS_KQT); bf16_t* VWoT = (bf16_t*)(ws + WS_VWOT);
    bf16_t* Rb = (bf16_t*)(ws + WS_RB); bf16_t* act = (bf16_t*)(ws + WS_BIG); bf16_t* proj = (bf16_t*)(ws + WS_PROJ); bf16_t* mix = (bf16_t*)(ws + WS_MIX);
    unsigned char* Ps8 = ws + WS_PS; unsigned char* X8 = ws + WS_PS + 64 * MiB; (void)F8_SK;
    const int lo = args.ph_lo, hi = args.ph_hi;
    cg::grid_group grid = cg::this_grid();
#define IN(k) (lo <= (k) && (k) < hi)
    unsigned* barw = (unsigned*)ws;
    unsigned* readyw = barw + 4096;
    constexpr unsigned READY_MAGIC = 0x600DF00Du;
    volatile LAS unsigned* xbst = (volatile LAS unsigned*)(ldsl + XBST_OFF);
    if (tid < 4) xbst[tid] = 0u;
    __syncthreads();
    if (lo < 0) grid.sync();
    if (bx == 0) {
        for (int i = tid; i < XCD_BAR_WORDS; i += 512) barw[i] = 0u;
        __threadfence(); __syncthreads();
        if (tid == 0) { __builtin_amdgcn_fence(__ATOMIC_RELEASE, "agent"); asm volatile("s_waitcnt vmcnt(0)" ::: "memory"); __hip_atomic_store(readyw, READY_MAGIC, __ATOMIC_RELAXED, __HIP_MEMORY_SCOPE_AGENT); }
    }
    XcdBarrier xbar; xbar.bar = barw; xbar.x = 0; xbar.st = xbst;
#define SEAM(k) do { if (IN(k) && IN((k) + 1)) { if ((k) == 0) { \
        if (tid == 0) { unsigned sp_ = 0; while (__hip_atomic_load(readyw, __ATOMIC_RELAXED, __HIP_MEMORY_SCOPE_AGENT) != READY_MAGIC) { __builtin_amdgcn_s_sleep(1); if (++sp_ > (1u << 22)) break; } \
            __builtin_amdgcn_fence(__ATOMIC_ACQUIRE, "agent"); asm volatile("s_waitcnt vmcnt(0)" ::: "memory"); } \
        __syncthreads(); xbar = xcd_barrier_post(barw, xbst); } \
        xcd_barrier(xbar); } } while (0)
#ifndef PROBE_DUP
#define PROBE_DUP 0
#endif
#define REP(k) for (int rep_ = 0; rep_ < 1 + ((PROBE_DUP >> (k)) & 1); ++rep_)

    if (IN(0)) REP(0) {
        LAS float* scr = (LAS float*)(ldsl + wave * 16384);
        constexpr int I_G = (DM / 64) * (DFF / 32), I_D = (DFF / 64) * (DM / 32), I_INQ = 16 * 16, I_INKV = 16 * 32, I_SQ = 16 * 32, I_KV = 16 * 64;
        constexpr int NITEMS = 4 * I_G + 2 * I_D + I_INQ + I_INKV + 2 * I_SQ + I_KV;
        for (int it = gw; it < NITEMS; it += NGW) {
            int r = it; const float* W; int ldw, col0 = 0, K = DM, N; const float* gain = nullptr; float scale = 1.f; bf16_t* WT; int rmode = 0, roff = 0;
            if (r < I_G) { W = args.in[3]; ldw = DFF; N = DFF; gain = args.in[2]; WT = Wgu1; rmode = 1; }
            else if ((r -= I_G) < I_G) { W = args.in[4]; ldw = DFF; N = DFF; gain = args.in[2]; WT = Wgu1; rmode = 2; }
            else if ((r -= I_G) < I_D) { W = args.in[5]; ldw = DM; N = DM; K = DFF; WT = Wd1; }
            else if ((r -= I_D) < I_INQ) { W = args.in[7]; ldw = INC; N = 512; gain = args.in[6]; scale = C2_SB; WT = Win; }
            else if ((r -= I_INQ) < I_INKV) { W = args.in[7]; ldw = INC; col0 = 512; N = 1024; gain = args.in[6]; WT = Win; roff = 512; }
            else if ((r -= I_INKV) < I_SQ) { W = args.in[10]; ldw = DM; N = DM; WT = Wout; }
            else if ((r -= I_SQ) < I_KV) { W = args.in[14]; ldw = 2 * DM; N = 2 * DM; WT = Wkv; }
            else if ((r -= I_KV) < I_SQ) { W = args.in[15]; ldw = DM; N = DM; WT = Wo; }
            else if ((r -= I_SQ) < I_G) { W = args.in[17]; ldw = DFF; N = DFF; gain = args.in[16]; WT = Wgu2; rmode = 1; }
            else if ((r -= I_G) < I_G) { W = args.in[18]; ldw = DFF; N = DFF; gain = args.in[16]; WT = Wgu2; rmode = 2; }
            else { r -= I_G; W = args.in[19]; ldw = DM; N = DM; K = DFF; WT = Wd2; }
            const int nblk = N / 32, kb = r / nblk, nb = r % nblk, k0 = 64 * kb, n0 = 32 * nb;
            const int drow0 = rmode == 0 ? roff + n0 : (n0 >> 7) * 256 + (rmode == 2 ? 128 : 0) + (n0 & 127);
            p0_transpose_item(W, ldw, col0 + n0, K, gain, scale, WT, drow0, k0, scr, lane);
        }
        if ((wave & 3) == 0) {
            const float* w_in = args.in[7]; const float* w_pool = args.in[8]; const float* pscale = args.in[9]; const float* gmix = args.in[6];
            for (int item = bx * 2 + (wave >> 2); item < 16 * 32; item += G * 2) {
                const int k = (item & 15) * 64 + lane, gd0 = item >> 4, g = gd0 >> 3, d0 = (gd0 & 7) * 16;
                const float* wr = w_in + (size_t)k * INC + 1536 + g * 128; const float* wp = w_pool + (size_t)g * 128 * 128 + d0;
                f32x4 a0 = {0.f, 0.f, 0.f, 0.f}, a1 = a0, a2 = a0, a3 = a0;
#pragma unroll 2
                for (int c = 0; c < 128; c += 4) { const f32x4 av = *(const f32x4*)(wr + c);
#pragma unroll
                    for (int e = 0; e < 4; ++e) { const f32x4* w4 = (const f32x4*)(wp + (size_t)(c + e) * 128); const float ae = av[e];
                        a0 += w4[0] * ae; a1 += w4[1] * ae; a2 += w4[2] * ae; a3 += w4[3] * ae; } }
                const float gk = gmix[k]; const f32x4* ps4 = (const f32x4*)(pscale + g * 128 + d0);
                a0 = a0 * ps4[0] * gk; a1 = a1 * ps4[1] * gk; a2 = a2 * ps4[2] * gk; a3 = a3 * ps4[3] * gk;
                bf16_t* o = Win + (size_t)(1536 + g * 128 + d0) * DM + k;
#pragma unroll
                for (int e = 0; e < 4; ++e) { o[(size_t)(e) * DM] = (bf16_t)(cvt_pk_bf16(a0[e], 0.f) & 0xffffu); o[(size_t)(4 + e) * DM] = (bf16_t)(cvt_pk_bf16(a1[e], 0.f) & 0xffffu);
                    o[(size_t)(8 + e) * DM] = (bf16_t)(cvt_pk_bf16(a2[e], 0.f) & 0xffffu); o[(size_t)(12 + e) * DM] = (bf16_t)(cvt_pk_bf16(a3[e], 0.f) & 0xffffu); }
            }
        }
        for (int m = gw; m < DM; m += NGW) {
            const f32x4* wr4 = (const f32x4*)(args.in[13] + (size_t)m * DM) + lane; const float gk = args.in[11][m] * C2_MEM; u32x2* o8 = (u32x2*)(Wq + (size_t)m * DM) + lane;
#pragma unroll
            for (int j = 0; j < 4; ++j) { const f32x4 v = wr4[64 * j] * gk; o8[64 * j] = (u32x2){cvt_pk_bf16(v[0], v[1]), cvt_pk_bf16(v[2], v[3])}; }
        }
        for (int m0 = gw * 4; m0 < T; m0 += NGW * 4) {
            f32x4 v[4][4]; float s[4];
#pragma unroll
            for (int r = 0; r < 4; ++r) { const f32x4* xr = (const f32x4*)(x + (size_t)(m0 + r) * DM) + lane;
#pragma unroll
                for (int j = 0; j < 4; ++j) v[r][j] = __builtin_nontemporal_load(xr + 64 * j); }
#pragma unroll
            for (int r = 0; r < 4; ++r) { s[r] = 0.f;
#pragma unroll
                for (int j = 0; j < 4; ++j) s[r] += dot4(v[r][j]);
                s[r] = wave_sum(s[r]);
                u32x2* o8 = (u32x2*)(Rb + (size_t)(m0 + r) * DM) + lane;
#pragma unroll
                for (int j = 0; j < 4; ++j) o8[64 * j] = (u32x2){cvt_pk_bf16(v[r][j][0], v[r][j][1]), cvt_pk_bf16(v[r][j][2], v[r][j][3])};
                if (lane < 4) ssq[(size_t)(m0 + r) * 4 + lane] = lane == 0 ? s[r] : 0.f; }
        }
        for (int m = gw; m < TM; m += NGW) {
            const f32x4* xr = (const f32x4*)(mem + (size_t)m * DM) + lane; const f32x4* gr = (const f32x4*)args.in[12] + lane; f32x4 v[4]; float s = 0.f;
#pragma unroll
            for (int j = 0; j < 4; ++j) { v[j] = xr[64 * j]; s += dot4(v[j]); }
            const float rs = __builtin_amdgcn_rsqf(wave_sum(s) * (1.f / DM) + EPS);
            u32x2* o8 = (u32x2*)(memn + (size_t)m * DM) + lane;
#pragma unroll
            for (int j = 0; j < 4; ++j) { const f32x4 gg = gr[64 * j]; const f32x4 y = v[j] * rs * gg; o8[64 * j] = (u32x2){cvt_pk_bf16(y[0], y[1]), cvt_pk_bf16(y[2], y[3])}; }
        }
        __syncthreads();
    }
    SEAM(0);
    if (IN(1)) REP(1) {
        pg8::Gemm g{Rb, Wgu1, DM, DM, DM, (long)256 * DM * 2, 0, (long)256 * DM * 2, 0, 30, 0}; pg8::StaticOrder S; S.init(T, 2 * DFF, G, bx, 1);
        pg8::EpiSwiGLU E{act, ssq};
        pg8::gemm_phase<pg8::EpiSwiGLU, 8>(ldsl, ldsl + SCR_OFF, g, S, E);
    }
    SEAM(1);
    if (IN(2)) REP(2) {
        pg8::Gemm g{act, Wd1, DFF, DFF, DFF, (long)256 * DFF * 2, 0, (long)256 * DFF * 2, 0, 30, 0}; pg8::StaticOrder S; S.init(T, DM, G, bx);
        pg8::EpiResid E{Rb, ssq, 0.5f};
        pg8::gemm_phase<pg8::EpiResid, 32>(ldsl, ldsl + SCR_OFF, g, S, E);
    }
    SEAM(2);
    if (IN(3)) REP(3) {
        {   pg8::Gemm g{Rb, Win, DM, DM, DM, (long)256 * DM * 2, 0, (long)256 * DM * 2, 0, 30, 0}; pg8::StaticOrder S; S.init(T, INC, G, bx, 1);
            pg8::EpiScale E{proj, INC, ssq, (long)256 * INC, 256, 30, 0};
            pg8::gemm_phase<pg8::EpiScale, 16>(ldsl, ldsl + SCR_OFF, g, S, E); }
        {
            pg8::Gemm g{memn, Wkv, DM, DM, DM, (long)256 * DM * 2, 0, (long)256 * DM * 2, 0, 30, 0}; pg8::StaticOrder S; S.init(TM, 2 * DM, G, bx);
            pg8::EpiScale E{KV, 2 * DM, nullptr, (long)256 * 2 * DM, 256, 30, 0};
            pg8::gemm_phase<pg8::EpiScale, 16>(ldsl, ldsl + SCR_OFF, g, S, E); }
    }
    SEAM(3);
    if (IN(4)) REP(4) {
        for (int u = bx; u < BATCH * 2 * 16; u += G) {
            const int i = u >> 8, xcd = u & 7, l = (u >> 3) & 31, qb2 = ((l & 15) + 5 * i) & 15, bh2 = (xcd + 8 * i) * 2 + (l >> 4);
            sb::sb_unit8(bh2 >> 1, bh2 & 1, qb2, proj, mix, (char*)lds, (volatile LAS unsigned*)(ldsl + SCR_OFF)); }
        for (int item = gw; item < (T / 64) * 4; item += NGW) {
            const int g = item & 3, t0 = (item >> 2) * 64 + (lane >> 4) * 16, c0 = g * 128 + (lane & 15) * 8;
            const bf16_t* y = proj + (size_t)t0 * INC + 1536 + c0; bf16_t* o = mix + (size_t)t0 * DM + 512 + c0; const int pos0 = t0 & (SEQ - 1);
            if (g == 0) pool_item<2>(y, o, pos0); else if (g == 1) pool_item<4>(y, o, pos0); else if (g == 2) pool_item<8>(y, o, pos0); else pool_item<16>(y, o, pos0);
        }
        __syncthreads();
        {
            pg8::Gemm g{KV, Wq, 2 * DM, DM, 256, (long)256 * 2 * DM * 2, 256 * 2, (long)256 * DM * 2, 0, 2, 256 * 2}; pg8::StaticOrder S; S.init(TM, 4 * DM, G, bx);
            pg8::EpiScale8K E{KqT, DM, nullptr, (long)DM * DM, 256, 2, (long)256 * DM};
            pg8::gemm_phase<pg8::EpiScale8K, 16>(ldsl, ldsl + SCR_OFF, g, S, E); }
        {
            pg8::Gemm g{Wo, KV + DM, DM, 2 * DM, 256, (long)256 * DM * 2, 256 * 2, (long)256 * 2 * DM * 2, 0, 5, 256 * 2}; pg8::StaticOrder S; S.init(DM, 4 * TM, G, bx);
            pg8::EpiScale8V E{VWoT, DM, nullptr, (long)256 * DM, (long)DM * DM, 5, 256};
            pg8::gemm_phase<pg8::EpiScale8V, 16>(ldsl, ldsl + SCR_OFF, g, S, E); }
    }
    SEAM(4);
    if (IN(5)) {
        pg8::Gemm g{mix, Wout, DM, DM, DM, (long)256 * DM * 2, 0, (long)256 * DM * 2, 0, 30, 0}; pg8::StaticOrder S; S.init(T, DM, G, bx, 1);
        pg8::EpiResid8 E{Rb, ssq, 1.0f};
        pg8::gemm_phase<pg8::EpiResid8, 32>(ldsl, ldsl + SCR_OFF, g, S, E);
    }
    SEAM(5);
    if (IN(6)) REP(6) {
        pg8::Gemm g{(const bf16_t*)X8, (const bf16_t*)KqT, DM / 2, DM / 2, DM / 2, (long)256 * DM, 0, 0, (long)DM * DM, 0, (long)256 * DM}; pg8::StaticOrder S; S.init(T, DM, G, bx);
        pg8::EpiSoftmax E{Ps8, ssq};
        pg8::gemm_phase<pg8::EpiSoftmax, 0, true>(ldsl, ldsl + SCR_OFF, g, S, E);
    }
    SEAM(6);
    if (IN(7)) {
        pg8::Gemm g{(const bf16_t*)Ps8, (const bf16_t*)VWoT, DM / 2, DM / 2, DM / 2, (long)256 * DM, 0, (long)256 * DM, (long)DM * DM, 30, 0}; pg8::StaticOrder S; S.init(T, DM, G, bx, 1);
        pg8::EpiResid E{Rb, ssq, 1.0f / (256.0f * F8_SV)};
        pg8::gemm_phase<pg8::EpiResid, 32, true>(ldsl, ldsl + SCR_OFF, g, S, E);
    }
    SEAM(7);
    if (IN(8)) REP(8) {
        pg8::Gemm g{Rb, Wgu2, DM, DM, DM, (long)256 * DM * 2, 0, (long)256 * DM * 2, 0, 30, 0}; pg8::StaticOrder S; S.init(T, 2 * DFF, G, bx);
        pg8::EpiSwiGLU E{act, ssq};
        pg8::gemm_phase<pg8::EpiSwiGLU, 8>(ldsl, ldsl + SCR_OFF, g, S, E);
    }
    SEAM(8);
    if (IN(9)) {
        pg8::Gemm g{act, Wd2, DFF, DFF, DFF, (long)256 * DFF * 2, 0, (long)256 * DFF * 2, 0, 30, 0}; pg8::StaticOrder S; S.init(T, DM, G, bx, 1);
        pg8::EpiResid E{Rb, ssq, 0.5f};
        pg8::gemm_phase<pg8::EpiResid, 32>(ldsl, ldsl + SCR_OFF, g, S, E);
    }
    SEAM(9);
    if (IN(10)) {
        const f32x4* gr = (const f32x4*)args.in[20]; f32x4 g0[2], g1[2];
#pragma unroll
        for (int j = 0; j < 2; ++j) { g0[j] = gr[(lane + 64 * j) * 2]; g1[j] = gr[(lane + 64 * j) * 2 + 1]; }
        for (int m0 = gw * 8; m0 < T; m0 += NGW * 8) {
            u32x4 v[8][2]; f32x4 sq[8];
#pragma unroll
            for (int r = 0; r < 8; ++r) { const u32x4* xr = (const u32x4*)(Rb + (size_t)(m0 + r) * DM) + lane; v[r][0] = xr[0]; v[r][1] = xr[64]; sq[r] = *(const f32x4*)(ssq + (size_t)(m0 + r) * 4); }
#pragma unroll
            for (int r = 0; r < 8; ++r) { const float rs = rstd4(sq[r]); f32x4* xw = (f32x4*)(out + (size_t)(m0 + r) * DM);
#pragma unroll
                for (int j = 0; j < 2; ++j) { const u32x4 b = v[r][j];
                    const f32x4 b0 = {bf_lo(b.x), bf_hi(b.x), bf_lo(b.y), bf_hi(b.y)}, b1 = {bf_lo(b.z), bf_hi(b.z), bf_lo(b.w), bf_hi(b.w)};
                    __builtin_nontemporal_store(b0 * rs * g0[j], xw + (lane + 64 * j) * 2); __builtin_nontemporal_store(b1 * rs * g1[j], xw + (lane + 64 * j) * 2 + 1); } }
        }
    }
    if (bx == 0 && tid == 0) __hip_atomic_store(readyw, 0u, __ATOMIC_RELAXED, __HIP_MEMORY_SCOPE_AGENT);
#undef IN
#undef SEAM
}

extern "C" void kernel_launch(void* const* d_in, const int* in_sizes, int n_in, void* d_out, int out_size, void* d_ws, size_t ws_size, hipStream_t stream) {
    static int grid = 0;
    if (grid == 0) {
        if (n_in != 21 || out_size != T * DM || ws_size < WS_END) { fprintf(stderr, "kernel_launch: unexpected problem (n_in %d out %d ws %zu)\n", n_in, out_size, ws_size); grid = -1; return; }
        int dev = 0, cus = 0, per_cu = 0;
        hipGetDevice(&dev); hipDeviceGetAttribute(&cus, hipDeviceAttributeMultiprocessorCount, dev);
        if (hipFuncSetAttribute((const void*)fwd_megakernel, hipFuncAttributeMaxDynamicSharedMemorySize, LDS_BYTES) != hipSuccess) { fprintf(stderr, "kernel_launch: hipFuncSetAttribute failed\n"); grid = -1; return; }
        if (hipOccupancyMaxActiveBlocksPerMultiprocessor(&per_cu, (const void*)fwd_megakernel, 512, LDS_BYTES) != hipSuccess || per_cu < 1) { fprintf(stderr, "kernel_launch: occupancy query says %d\n", per_cu); per_cu = 1; }
        (void)hipGetLastError();
        grid = cus * 1;
        (void)per_cu;
    }
    if (grid < 0) return;
    Args a{};
    for (int i = 0; i < 21; ++i) a.in[i] = (const float*)d_in[i];
    a.out = (float*)d_out; a.ws = (unsigned char*)d_ws;
#if MK_LAUNCHES_PER_PHASE
    for (int p = 0; p < NPHASE; ++p) { a.ph_lo = p; a.ph_hi = p + 1; hipLaunchKernelGGL(fwd_megakernel, dim3(grid), dim3(512), LDS_BYTES, stream, a); }
#else
    a.ph_lo = 0; a.ph_hi = NPHASE;
    void* kargs[] = {&a};
    hipError_t e = hipLaunchCooperativeKernel((const void*)fwd_megakernel, dim3(grid), dim3(512), kargs, LDS_BYTES, stream);
    if (e != hipSuccess) fprintf(stderr, "cooperative launch failed: %s (grid %d)\n", hipGetErrorString(e), grid);
#endif
}
```
